# Optimizing an MI355X kernel written in HIP

```python
import math
import jax
import jax.numpy as jnp
from jax import lax
import numpy as np

D_MODEL = 2048
BATCH = 4
SEQ = 4096
DEPTH = 2

GRID_W = 64
CTX_LEN = 256
N_EVEN = (DEPTH + 1) // 2
N_ODD = DEPTH // 2
N_MOD = 6
EPS = 1e-6
NEG_INF = -1e30

A_WIDTH = D_MODEL // 2
S5_GROUP = 16
S5_GROUPS = A_WIDTH // S5_GROUP
S5_STATE = 64
B_WIDTH = D_MODEL // 2
GLA_HEADS = 4
GLA_DV = B_WIDTH // GLA_HEADS
GLA_DK = GLA_DV // 2
GLA_QK = GLA_HEADS * GLA_DK
GLA_RANK = 16
GLA_TAU = 16.0
GLA_CHUNK = 64
AB_IN = A_WIDTH + 2 * GLA_QK + 2 * B_WIDTH + 2 * GLA_RANK
AB_OUT = A_WIDTH + B_WIDTH
NA_HEAD_DIM = 128
NA_HEADS = D_MODEL // NA_HEAD_DIM
NA_KH_MAX = 8
NA_KW = 16
ROPE_THETA = 10000.0
MOE_GROUPS = 4
MOE_PER_GROUP = 8
MOE_EXPERTS = MOE_GROUPS * MOE_PER_GROUP
MOE_HIDDEN = D_MODEL // 2
MOE_TOP_K = 2
MOE_BLOCK = 128

F32 = jnp.float32

kernel_name = 'hybrid_s5_gla_natten_hmoe_block'


def rmsnorm(x, g):
    x32 = x.astype(F32)
    y = x32 * lax.rsqrt(jnp.mean(x32 * x32, axis=-1, keepdims=True) + EPS)
    return (y * g.astype(F32)).astype(x.dtype)


def modulate(x, g, shift, scale):
    return rmsnorm(x, g) * (1 + scale) + shift


def axial_rope(t):
    L, d = t.shape[1], t.shape[-1]
    half = d // 2
    nf = half // 2
    inv = ROPE_THETA ** (-jnp.arange(nf, dtype=F32) / nf)
    pos = jnp.arange(L)

    def rot(z, p):
        ang = p.astype(F32)[:, None] * inv[None, :]
        cos = jnp.cos(ang)[None, :, None, :]
        sin = jnp.sin(ang)[None, :, None, :]
        z1, z2 = z[..., :nf], z[..., nf:]
        return jnp.concatenate([z1 * cos - z2 * sin, z1 * sin + z2 * cos], axis=-1)

    t32 = t.astype(F32)
    out = jnp.concatenate([rot(t32[..., :half], pos // GRID_W), rot(t32[..., half:], pos % GRID_W)], axis=-1)
    return out.astype(t.dtype)


def s5_scan(u, h0_re, h0_im, lam_re, lam_im, log_dt, b_re, b_im, c_re, c_im):
    lr = jnp.minimum(lam_re.astype(F32), -1e-4)
    li = lam_im.astype(F32)
    dt = jnp.exp(log_dt.astype(F32))[:, None]
    mag = jnp.exp(lr * dt)
    abar_re = mag * jnp.cos(li * dt)
    abar_im = mag * jnp.sin(li * dt)
    num_re = abar_re - 1.0
    den = lr * lr + li * li
    f_re = (num_re * lr + abar_im * li) / den
    f_im = (abar_im * lr - num_re * li) / den
    bu_re = jnp.einsum('blgi,gpi->blgp', u, b_re.astype(F32))
    bu_im = jnp.einsum('blgi,gpi->blgp', u, b_im.astype(F32))
    x_re = f_re * bu_re - f_im * bu_im
    x_im = f_re * bu_im + f_im * bu_re
    L = u.shape[1]
    a_re = jnp.broadcast_to(abar_re, (1, L) + abar_re.shape)
    a_im = jnp.broadcast_to(abar_im, (1, L) + abar_im.shape)

    def combine(e1, e2):
        a1r, a1i, b1r, b1i = e1
        a2r, a2i, b2r, b2i = e2
        return (a2r * a1r - a2i * a1i, a2r * a1i + a2i * a1r,
                a2r * b1r - a2i * b1i + b2r, a2r * b1i + a2i * b1r + b2i)

    pr, pim, hr, hi = lax.associative_scan(combine, (a_re, a_im, x_re, x_im), axis=1)
    h0r, h0i = h0_re[:, None], h0_im[:, None]
    hr = hr + pr * h0r - pim * h0i
    hi = hi + pr * h0i + pim * h0r
    y = jnp.einsum('blgp,gip->blgi', hr, c_re.astype(F32)) - jnp.einsum('blgp,gip->blgi', hi, c_im.astype(F32))
    return y, hr[:, -1], hi[:, -1]


def s5_mixer(u_x, u_c, lam_re, lam_im, log_dt, b_re, b_im, c_re, c_im, d_skip, w_glu):
    def groups(u):
        return u.astype(F32).reshape(u.shape[0], u.shape[1], S5_GROUPS, S5_GROUP)

    ux, uc = groups(u_x), groups(u_c)
    zero = jnp.zeros((u_x.shape[0], S5_GROUPS, S5_STATE), F32)

    def prm(d):
        return (lam_re[d], lam_im[d], log_dt[d], b_re[d], b_im[d], c_re[d], c_im[d])

    def flip(t):
        return jnp.flip(t, axis=1)

    yc_f, hf_re, hf_im = s5_scan(uc, zero, zero, *prm(0))
    yx_f, _, _ = s5_scan(ux, hf_re, hf_im, *prm(0))
    yc_b, hb_re, hb_im = s5_scan(flip(uc), zero, zero, *prm(1))
    yx_b, _, _ = s5_scan(flip(ux), hb_re, hb_im, *prm(1))
    dsk = d_skip.astype(F32).reshape(S5_GROUPS, S5_GROUP)
    wg = w_glu.astype(F32)

    def out(u, yf, yb, like):
        Bn, L = u.shape[:2]
        y = (yf + flip(yb) + dsk * u).reshape(Bn, L, A_WIDTH)
        g = jax.nn.gelu(y)
        return (g * jax.nn.sigmoid(g @ wg)).astype(like.dtype)

    return out(ux, yx_f, yx_b, u_x), out(uc, yc_f, yc_b, u_c)


def gla_chunked(q, k, v, log_a, s0):
    Bn, H, L, dk = q.shape
    dv = v.shape[-1]
    n, C = L // GLA_CHUNK, GLA_CHUNK
    q = q.reshape(Bn, H, n, C, dk)
    k = k.reshape(Bn, H, n, C, dk)
    v = v.reshape(Bn, H, n, C, dv)
    b = jnp.cumsum(log_a.reshape(Bn, H, n, C, dk), axis=3)
    b_last = b[:, :, :, -1:, :]
    q_in = q * jnp.exp(b)
    k_in = k * jnp.exp(-b)
    k_out = k * jnp.exp(b_last - b)
    mask = jnp.tril(jnp.ones((C, C), dtype=bool))
    att = jnp.where(mask, jnp.einsum('bhncd,bhnsd->bhncs', q_in, k_in), 0.0)
    o = jnp.einsum('bhncs,bhnse->bhnce', att, v)
    u_chunk = jnp.einsum('bhncd,bhnce->bhnde', k_out, v)
    decay = jnp.exp(b_last[:, :, :, 0, :])

    def step(s, inp):
        dec, uc = inp
        return dec[..., None] * s + uc, s

    s_fin, s_before = lax.scan(step, s0, (jnp.moveaxis(decay, 2, 0), jnp.moveaxis(u_chunk, 2, 0)))
    s_before = jnp.moveaxis(s_before, 0, 2)
    o = o + jnp.einsum('bhncd,bhnde->bhnce', q_in, s_before)
    return o.reshape(Bn, H, L, dv), s_fin


def gla_mixer(p_x, p_c, w_gate2, b_gate, norm_g):
    o1 = GLA_QK
    o2 = 2 * GLA_QK
    o3 = o2 + B_WIDTH
    o4 = o3 + B_WIDTH

    def prep(p, rope):
        Bn, L, _ = p.shape
        q = p[..., :o1].reshape(Bn, L, GLA_HEADS, GLA_DK)
        k = p[..., o1:o2].reshape(Bn, L, GLA_HEADS, GLA_DK)
        v = p[..., o2:o3].reshape(Bn, L, GLA_HEADS, GLA_DV)
        r = p[..., o3:o4]
        lowrank = p[..., o4:]
        if rope:
            q, k = axial_rope(q), axial_rope(k)
        q = q * GLA_DK ** -0.5

        def gate(d):
            z = lowrank[..., d * GLA_RANK:(d + 1) * GLA_RANK] @ w_gate2[d] + b_gate[d]
            return (jax.nn.log_sigmoid(z.astype(F32)) / GLA_TAU).reshape(Bn, L, GLA_HEADS, GLA_DK)

        def bhld(t):
            return jnp.swapaxes(t, 1, 2).astype(F32)

        return bhld(q), bhld(k), bhld(v), r, bhld(gate(0)), bhld(gate(1))

    qx, kx, vx, rx, ax_f, ax_b = prep(p_x, True)
    qc, kc, vc, rc, ac_f, ac_b = prep(p_c, False)
    s0 = jnp.zeros((qx.shape[0], GLA_HEADS, GLA_DK, GLA_DV), F32)

    def fl(t):
        return jnp.flip(t, axis=2)

    oc_f, sc_f = gla_chunked(qc, kc, vc, ac_f, s0)
    ox_f, _ = gla_chunked(qx, kx, vx, ax_f, sc_f)
    oc_b, sc_b = gla_chunked(fl(qc), fl(kc), fl(vc), fl(ac_b), s0)
    ox_b, _ = gla_chunked(fl(qx), fl(kx), fl(vx), fl(ax_b), sc_b)
    g = norm_g.astype(F32).reshape(GLA_HEADS, GLA_DV)

    def finish(o, r):
        o = jnp.swapaxes(o, 1, 2)
        o = o * lax.rsqrt(jnp.mean(o * o, axis=-1, keepdims=True) + EPS) * g
        Bn, L = o.shape[:2]
        return (o.reshape(Bn, L, B_WIDTH) * jax.nn.silu(r.astype(F32))).astype(r.dtype)

    return finish(ox_f + fl(ox_b), rx), finish(oc_f + fl(oc_b), rc)


def ab_mixer(hx, hc, w_in, w_out, s5_lam_re, s5_lam_im, s5_log_dt, s5_b_re, s5_b_im, s5_c_re, s5_c_im,
             s5_d, s5_w_glu, gla_w_gate2, gla_b_gate, gla_norm_g):
    px, pc = hx @ w_in, hc @ w_in
    ax, ac = s5_mixer(px[..., :A_WIDTH], pc[..., :A_WIDTH], s5_lam_re, s5_lam_im, s5_log_dt,
                      s5_b_re, s5_b_im, s5_c_re, s5_c_im, s5_d, s5_w_glu)
    bx, bc = gla_mixer(px[..., A_WIDTH:], pc[..., A_WIDTH:], gla_w_gate2, gla_b_gate, gla_norm_g)
    return (jnp.concatenate([ax, bx], axis=-1) @ w_out, jnp.concatenate([ac, bc], axis=-1) @ w_out)


def na_mixer(hx, hc, w_qkv, w_out, q_norm, k_norm, rpb, ctx_out):
    Bn, L, D = hx.shape
    rows = L // GRID_W
    kh = min(NA_KH_MAX, rows)
    scale = NA_HEAD_DIM ** -0.5

    def heads(h):
        qkv = (h @ w_qkv).reshape(h.shape[0], h.shape[1], 3, NA_HEADS, NA_HEAD_DIM)
        return rmsnorm(qkv[:, :, 0], q_norm), rmsnorm(qkv[:, :, 1], k_norm), qkv[:, :, 2]

    qx, kx, vx = heads(hx)
    qc, kc, vc = heads(hc)
    qg = qx.reshape(Bn, rows, GRID_W, NA_HEADS, NA_HEAD_DIM)
    kg = kx.reshape(Bn, rows, GRID_W, NA_HEADS, NA_HEAD_DIM)
    vg = vx.reshape(Bn, rows, GRID_W, NA_HEADS, NA_HEAD_DIM)
    col = jnp.arange(GRID_W)
    cs = jnp.clip(col - NA_KW // 2, 0, GRID_W - NA_KW)
    col_ok = (col[None, :] >= cs[:, None]) & (col[None, :] < cs[:, None] + NA_KW)
    dc_idx = jnp.clip(col[None, :] - col[:, None] + NA_KW - 1, 0, 2 * NA_KW - 2)
    rpb_c = rpb.astype(F32)[:, :, dc_idx]

    def row_block(r):
        start = jnp.clip(r - kh // 2, 0, rows - kh)
        q_r = lax.dynamic_index_in_dim(qg, r, axis=1, keepdims=False)
        k_b = lax.dynamic_slice_in_dim(kg, start, kh, axis=1).reshape(Bn, kh * GRID_W, NA_HEADS, NA_HEAD_DIM)
        v_b = lax.dynamic_slice_in_dim(vg, start, kh, axis=1).reshape(Bn, kh * GRID_W, NA_HEADS, NA_HEAD_DIM)
        dr_idx = start + jnp.arange(kh) - r + NA_KH_MAX - 1
        bias = jnp.take(rpb_c, dr_idx, axis=1).transpose(0, 2, 1, 3)
        bias = jnp.where(col_ok[None, :, None, :], bias, NEG_INF).reshape(NA_HEADS, GRID_W, kh * GRID_W)
        s_lat = jnp.einsum('bqhd,bkhd->bhqk', q_r, k_b).astype(F32) * scale + bias
        s_ctx = jnp.einsum('bqhd,bkhd->bhqk', q_r, kc).astype(F32) * scale
        p = jax.nn.softmax(jnp.concatenate([s_lat, s_ctx], axis=-1), axis=-1).astype(vx.dtype)
        nl = kh * GRID_W
        return (jnp.einsum('bhqk,bkhd->bqhd', p[..., :nl], v_b)
                + jnp.einsum('bhqk,bkhd->bqhd', p[..., nl:], vc))

    o = lax.map(row_block, jnp.arange(rows))
    o_x = jnp.moveaxis(o, 0, 1).reshape(Bn, L, D) @ w_out
    if not ctx_out:
        return o_x, None
    s = jnp.einsum('bqhd,bkhd->bhqk', qc, kc).astype(F32) * scale
    p = jax.nn.softmax(s, axis=-1).astype(vc.dtype)
    o_c = jnp.einsum('bhqk,bkhd->bqhd', p, vc).reshape(hc.shape) @ w_out
    return o_x, o_c


def hier_moe(h, w_route_group, w_route_expert, w_gate, w_up, w_down):
    N, D = h.shape
    g_prob = jax.nn.softmax((h @ w_route_group).astype(F32), axis=-1)
    p_top, g_idx = lax.top_k(g_prob, 1)
    e_logits = (h @ w_route_expert).astype(F32).reshape(N, MOE_GROUPS, MOE_PER_GROUP)
    e_sel = jnp.take_along_axis(e_logits, g_idx[:, :, None], axis=1)[:, 0]
    e_val, e_idx = lax.top_k(e_sel, MOE_TOP_K)
    w = jax.nn.softmax(e_val, axis=-1) * p_top
    eid = (g_idx * MOE_PER_GROUP + e_idx).reshape(-1)
    tok = jnp.repeat(jnp.arange(N, dtype=jnp.int32), MOE_TOP_K)
    wt = w.reshape(-1)
    M = N * MOE_TOP_K
    order = jnp.argsort(eid)
    s_eid, s_tok, s_w = eid[order], tok[order], wt[order]
    counts = jnp.bincount(eid, length=MOE_EXPERTS)
    padded = (counts + MOE_BLOCK - 1) // MOE_BLOCK * MOE_BLOCK
    start = jnp.cumsum(counts) - counts
    pend = jnp.cumsum(padded)
    pstart = pend - padded
    dest = pstart[s_eid] + jnp.arange(M) - start[s_eid]
    P = (M + MOE_EXPERTS * (MOE_BLOCK - 1) + MOE_BLOCK - 1) // MOE_BLOCK * MOE_BLOCK
    nb = P // MOE_BLOCK
    buf_tok = jnp.full((P,), N, jnp.int32).at[dest].set(s_tok)
    buf_w = jnp.zeros((P,), F32).at[dest].set(s_w)
    blk_e = jnp.minimum(jnp.searchsorted(pend, jnp.arange(nb) * MOE_BLOCK, side='right'), MOE_EXPERTS - 1)
    h_pad = jnp.concatenate([h, jnp.zeros((1, D), h.dtype)], axis=0)
    xb = h_pad[buf_tok].reshape(nb, MOE_BLOCK, D)

    def expert_block(args):
        xblk, e = args
        return (jax.nn.silu(xblk @ w_gate[e]) * (xblk @ w_up[e])) @ w_down[e]

    yb = lax.map(expert_block, (xb, blk_e)).reshape(P, D)
    y = jax.ops.segment_sum(yb * buf_w.astype(yb.dtype)[:, None], buf_tok, num_segments=N + 1)
    return y[:N]


def setup_inputs(seed: int = 0) -> dict:
    key = jax.random.key(seed)
    ks = jax.random.split(key, 40)

    def nrm(i, shape, s):
        return jax.random.normal(ks[i], shape, F32) * s

    D = D_MODEL
    G, P, I = S5_GROUPS, S5_STATE, S5_GROUP
    E, F = MOE_EXPERTS, MOE_HIDDEN
    lam_im = jnp.broadcast_to(math.pi * jnp.arange(P, dtype=F32), (N_EVEN, 2, G, P))
    return {
        'x': nrm(0, (BATCH, SEQ, D), 1.0),
        'c': nrm(1, (BATCH, D), 1.0),
        'ctx': nrm(2, (BATCH, CTX_LEN, D), 1.0),
        'c_ctx': nrm(3, (D,), 1.0),
        'ada_w': nrm(4, (DEPTH, D, N_MOD * D), 0.5 * D ** -0.5),
        'ada_b': nrm(5, (DEPTH, N_MOD * D), 0.02),
        'norm1_g': 1.0 + nrm(6, (DEPTH, D), 0.02),
        'norm2_g': 1.0 + nrm(7, (DEPTH, D), 0.02),
        'ab_w_in': nrm(8, (N_EVEN, D, AB_IN), D ** -0.5),
        'ab_w_out': nrm(9, (N_EVEN, AB_OUT, D), AB_OUT ** -0.5),
        's5_lam_re': -0.5 + nrm(10, (N_EVEN, 2, G, P), 0.01),
        's5_lam_im': lam_im + nrm(11, (N_EVEN, 2, G, P), 0.01),
        's5_log_dt': jax.random.uniform(ks[12], (N_EVEN, 2, G), F32, minval=math.log(1e-3), maxval=math.log(1e-1)),
        's5_b_re': nrm(13, (N_EVEN, 2, G, P, I), (2 * I) ** -0.5),
        's5_b_im': nrm(14, (N_EVEN, 2, G, P, I), (2 * I) ** -0.5),
        's5_c_re': nrm(15, (N_EVEN, 2, G, I, P), P ** -0.5),
        's5_c_im': nrm(16, (N_EVEN, 2, G, I, P), P ** -0.5),
        's5_d': nrm(17, (N_EVEN, A_WIDTH), 1.0),
        's5_w_glu': nrm(18, (N_EVEN, A_WIDTH, A_WIDTH), A_WIDTH ** -0.5),
        'gla_w_gate2': nrm(19, (N_EVEN, 2, GLA_RANK, GLA_QK), GLA_RANK ** -0.5),
        'gla_b_gate': nrm(20, (N_EVEN, 2, GLA_QK), 0.1),
        'gla_norm_g': 1.0 + nrm(21, (N_EVEN, B_WIDTH), 0.02),
        'na_w_qkv': nrm(22, (N_ODD, D, 3 * D), D ** -0.5),
        'na_w_out': nrm(23, (N_ODD, D, D), D ** -0.5),
        'na_q_norm': 1.0 + nrm(24, (N_ODD, NA_HEAD_DIM), 0.02),
        'na_k_norm': 1.0 + nrm(25, (N_ODD, NA_HEAD_DIM), 0.02),
        'na_rpb': nrm(26, (N_ODD, NA_HEADS, 2 * NA_KH_MAX - 1, 2 * NA_KW - 1), 0.05),
        'moe_w_route_group': nrm(27, (DEPTH, D, MOE_GROUPS), D ** -0.5),
        'moe_w_route_expert': nrm(28, (DEPTH, D, E), D ** -0.5),
        'moe_w_gate': nrm(29, (DEPTH, E, D, F), D ** -0.5),
        'moe_w_up': nrm(30, (DEPTH, E, D, F), D ** -0.5),
        'moe_w_down': nrm(31, (DEPTH, E, F, D), F ** -0.5),
    }


def reference(x, c, ctx, c_ctx, ada_w, ada_b, norm1_g, norm2_g, ab_w_in, ab_w_out,
              s5_lam_re, s5_lam_im, s5_log_dt, s5_b_re, s5_b_im, s5_c_re, s5_c_im, s5_d, s5_w_glu,
              gla_w_gate2, gla_b_gate, gla_norm_g, na_w_qkv, na_w_out, na_q_norm, na_k_norm, na_rpb,
              moe_w_route_group, moe_w_route_expert, moe_w_gate, moe_w_up, moe_w_down):
    D = x.shape[-1]
    sc = jax.nn.silu(c)
    scc = jax.nn.silu(c_ctx)
    for i in range(DEPTH):
        j = i // 2
        last = i == DEPTH - 1
        mod_x = (sc @ ada_w[i] + ada_b[i])[:, None, :]
        mod_c = (scc @ ada_w[i] + ada_b[i])[None, None, :]
        sh1, sc1, g1, sh2, sc2, g2 = jnp.split(mod_x, N_MOD, axis=-1)
        csh1, csc1, cg1, csh2, csc2, cg2 = jnp.split(mod_c, N_MOD, axis=-1)
        hx = modulate(x, norm1_g[i], sh1, sc1)
        hc = modulate(ctx, norm1_g[i], csh1, csc1)
        if i % 2 == 0:
            ox, oc = ab_mixer(hx, hc, ab_w_in[j], ab_w_out[j], s5_lam_re[j], s5_lam_im[j], s5_log_dt[j],
                              s5_b_re[j], s5_b_im[j], s5_c_re[j], s5_c_im[j], s5_d[j], s5_w_glu[j],
                              gla_w_gate2[j], gla_b_gate[j], gla_norm_g[j])
        else:
            ox, oc = na_mixer(hx, hc, na_w_qkv[j], na_w_out[j], na_q_norm[j], na_k_norm[j], na_rpb[j],
                              not last)
        x = x + g1 * ox
        hx = modulate(x, norm2_g[i], sh2, sc2)
        moe_w = (moe_w_route_group[i], moe_w_route_expert[i], moe_w_gate[i], moe_w_up[i], moe_w_down[i])
        if last:
            x = x + g2 * hier_moe(hx.reshape(-1, D), *moe_w).reshape(x.shape)
        else:
            ctx = ctx + cg1 * oc
            hc = modulate(ctx, norm2_g[i], csh2, csc2)
            nx = hx.shape[0] * hx.shape[1]
            y = hier_moe(jnp.concatenate([hx.reshape(-1, D), hc.reshape(-1, D)], axis=0), *moe_w)
            x = x + g2 * y[:nx].reshape(x.shape)
            ctx = ctx + cg2 * y[nx:].reshape(ctx.shape)
    return x
```

```cpp
#include <hip/hip_runtime.h>
#include <cstdio>
#include <cstdint>

#define LAS __attribute__((address_space(3)))
#define GAS __attribute__((address_space(1)))
typedef unsigned short bf16;
typedef short bf16x8 __attribute__((ext_vector_type(8)));
typedef float f32x4 __attribute__((ext_vector_type(4)));
typedef float f32x2 __attribute__((ext_vector_type(2)));
typedef float f32x16 __attribute__((ext_vector_type(16)));
typedef unsigned u32x4 __attribute__((ext_vector_type(4)));
typedef unsigned u32x2 __attribute__((ext_vector_type(2)));
typedef GAS unsigned gu32;

constexpr int DM = 2048, NB = 4, SEQ = 4096, CTX = 256;
constexpr int NX = NB * SEQ, NC = NB * CTX, MT = NX + NC;
constexpr int NMOD = 6, MODW = NMOD * DM;
constexpr int AW = 1024, S5G = 64, S5I = 16, S5P = 64;
constexpr int GH = 4, GDV = 256, GDK = 128, GQK = 512, GRANK = 16;
constexpr int AB_IN = 4128, AB_IN_PAD = 4352;
constexpr int NAH = 16, NAD = 128;
constexpr int NE = 32, MOEF = 1024;
constexpr float EPS = 1e-6f;
constexpr int PMAX = 43008;
constexpr int S5T = 16, S5COLS = 1088, S5COLS_PAD = 1280;

constexpr size_t MiB = 1u << 20;
constexpr size_t WS_CTL = 0, CTL_ZERO_BYTES = 1 * MiB;
constexpr size_t WS_MOD = 1 * MiB;
constexpr size_t WS_WIN = 2 * MiB;
constexpr size_t WS_WGLU = WS_WIN + 17 * MiB;
constexpr size_t WS_WOUT = WS_WGLU + 2 * MiB;
constexpr size_t WS_WQKV = WS_WOUT + 8 * MiB;
constexpr size_t WS_WNAO = WS_WQKV + 24 * MiB;
constexpr size_t WS_WR = WS_WNAO + 8 * MiB;
constexpr size_t WS_WGU = WS_WR + 2 * MiB;
constexpr size_t WS_WD = WS_WGU + 256 * MiB;
constexpr size_t WS_SM = WS_WD + 128 * MiB;
constexpr size_t WS_SE = WS_SM + 16 * MiB;
constexpr size_t WS_XA = WS_SE + 8 * MiB;
constexpr size_t WS_H = WS_XA + 136 * MiB;
constexpr size_t WS_ACT = WS_H + 68 * MiB;
constexpr size_t WS_UEXT = WS_ACT;
constexpr size_t WS_LST = WS_UEXT + 80 * MiB;
constexpr size_t WS_GQ = WS_LST + 80 * MiB;
constexpr size_t WS_GK = WS_GQ + 17 * MiB;
constexpr size_t WS_GV = WS_GK + 17 * MiB;
constexpr size_t WS_GR = WS_GV + 34 * MiB;
constexpr size_t WS_LOWR = WS_GR + 34 * MiB;
constexpr size_t WS_LA = WS_LOWR + 3 * MiB;
constexpr size_t WS_G = WS_LA + 68 * MiB;
constexpr size_t WS_AB = WS_G + 34 * MiB;
constexpr size_t WS_UC = WS_AB + 68 * MiB;
constexpr size_t WS_DEC = WS_UC + 272 * MiB;
constexpr size_t WS_YD = WS_DEC + 2 * MiB;
constexpr size_t WS_MIX_END = WS_YD + 136 * MiB;
constexpr size_t WS_LOG = WS_ACT;
constexpr size_t WS_ROUTE = WS_LOG + 18 * MiB;
constexpr size_t WS_ROWW = WS_ROUTE + 1 * MiB;
constexpr size_t WS_LIST = WS_ROWW + 1 * MiB;
constexpr size_t WS_WLIST = WS_LIST + 3 * MiB;
constexpr size_t WS_HH = WS_WLIST + 3 * MiB;
constexpr size_t WS_Y = WS_HH + 84 * MiB;
constexpr size_t WS_MOE_END = WS_Y + 168 * MiB;
constexpr size_t WS_Q = WS_ACT;
constexpr size_t WS_K = WS_Q + 68 * MiB;
constexpr size_t WS_V = WS_K + 68 * MiB;
constexpr size_t WS_O = WS_V + 68 * MiB;
constexpr size_t WS_END = 2048 * MiB;
static_assert(WS_MIX_END <= WS_END && WS_MOE_END <= WS_END && WS_O + 64 * MiB <= WS_END, "d_ws map");

constexpr int CW_TMO = 0;
constexpr int CW_CNT0 = 256, CW_CNT1 = 512;
constexpr int CW_QCV = 1024, CW_QNA = 1280;
constexpr int CW_QC0 = 1536;
constexpr int CW_BAR = 4096;

constexpr int RING_BYTES = 131072;
constexpr int LDS_TAB = RING_BYTES;
constexpr int LDS_MISC = RING_BYTES + 4096;
constexpr int LDS_BYTES = 147456;

#define LDS_WAIT() asm volatile("s_waitcnt lgkmcnt(0)" ::: "memory")
#define VM_WAIT() asm volatile("s_waitcnt vmcnt(0)" ::: "memory")
__device__ __forceinline__ unsigned f2bf(float f) { unsigned u = __builtin_bit_cast(unsigned, f); return (u + 0x7fffu + ((u >> 16) & 1u)) >> 16; }
__device__ __forceinline__ unsigned pk2(float lo, float hi) { return f2bf(lo) | (f2bf(hi) << 16); }
__device__ __forceinline__ float bf2f(unsigned b) { return __builtin_bit_cast(float, b << 16); }
__device__ __forceinline__ float bflo(unsigned w) { return __builtin_bit_cast(float, w << 16); }
__device__ __forceinline__ float bfhi(unsigned w) { return __builtin_bit_cast(float, w & 0xffff0000u); }
__device__ __forceinline__ float wave_sum(float v) {
#pragma unroll
    for (int o = 1; o < 64; o <<= 1) v += __shfl_xor(v, o);
    return v;
}
__device__ __forceinline__ float wave_max(float v) {
#pragma unroll
    for (int o = 1; o < 64; o <<= 1) v = fmaxf(v, __shfl_xor(v, o));
    return v;
}
__device__ __forceinline__ float silu_f(float x) { return x * __builtin_amdgcn_rcpf(1.0f + __expf(-x)); }
__device__ __forceinline__ float sigmoid_f(float x) { return __builtin_amdgcn_rcpf(1.0f + __expf(-x)); }
__device__ __forceinline__ float gelu_tanh_f(float x) { const float z = 0.7978845608028654f * (x + 0.044715f * x * x * x); const float e = __expf(2.0f * z); return 0.5f * x * (2.0f - 2.0f * __builtin_amdgcn_rcpf(1.0f + e)); }
__device__ __forceinline__ void row_decode(int row, int& isctx, int& b, int& t) {
    if (row < NX) { isctx = 0; b = row >> 12; t = row & 4095; } else { const int rr = row - NX; isctx = 1; b = rr >> 8; t = rr & 255; }
}

#ifndef PROBE_EPI2
#define PROBE_EPI2 0
#endif
namespace pg8 {
#define PG8_LAS __attribute__((address_space(3)))
constexpr int BM = 256, BK = 64, HALF = 128, HTB = HALF * BK * 2, STAGE_BYTES = 8 * HTB, NXCD = 8, WGM = 8;
__host__ __device__ __forceinline__ int lds_byte(int r, int c) { const int st = (r >> 4) * 2 + (c >> 5), rr = r & 15, cc = c & 31, ob = rr * 64 + cc * 2; return st * 1024 + (ob ^ (((ob >> 9) & 1) << 5)); }
__host__ __device__ __forceinline__ void stage_rc(int b, int& R, int& C) { const int st = b / 1024, sb = b % 1024, swz = sb ^ (((sb >> 9) & 1) << 5); R = (st >> 1) * 16 + swz / 64; C = (st & 1) * 32 + (swz % 64) / 2; }
__host__ __device__ __forceinline__ int perm32(int rho) { const int n = rho >> 4, i = rho & 15; return 8 * (i >> 2) + 4 * n + (i & 3); }

struct Unit { int pm, pn; const char* A; const char* B; const int* rows; int nvalid; int skip; };
struct Gemm { int lda, ldb, K; };

__device__ __forceinline__ bool tile_order(long L, int nM, int nN, int& pm, int& pn) {
    const int nwg = nM * nN; if (L >= nwg) return false;
    int wgid = (int)L; { const int q = nwg / NXCD, r = nwg % NXCD, xcd = wgid % NXCD, off = wgid / NXCD; wgid = (xcd < r ? xcd * (q + 1) : r * (q + 1) + (xcd - r) * q) + off; }
    const int nig = WGM * nN, gid = wgid / nig, fm = gid * WGM, gsz = (nM - fm) < WGM ? (nM - fm) : WGM;
    pm = fm + ((wgid % nig) % gsz); pn = (wgid % nig) / gsz; return true;
}
struct DenseOrder {
    const char* A; const char* B; int lda, ldb, nM, nN, G, c; int split;
    __device__ __forceinline__ bool next(int i, Unit& u) const {
        long L = (long)i * G + c; u.skip = 0;
        if (split) {
            const int nwg = nM * nN, R = (nwg + G - 1) / G, T = nwg - (R - 1) * G;
            if (i == R - 1 && T < G) {
                const int S = (4 * T <= G) ? 4 : ((2 * T <= G) ? 2 : 1);
                if (c >= S * T) return false;
                const int part = c % S; L = (long)(R - 1) * G + c / S;
                if (S == 2) u.skip = part ? 1 : 2;
                if (S == 4) u.skip = ((part & 1) ? 1 : 2) | ((part >> 1) ? 4 : 8);
            }
        }
        if (!tile_order(L, nM, nN, u.pm, u.pn)) return false;
        u.A = A + (size_t)u.pm * BM * lda * 2; u.B = B + (size_t)u.pn * BM * ldb * 2; return true;
    }
};
struct GroupOrder {
    const char* A; const char* B; int lda, ldb, nM, nN, G, c; size_t estride; const PG8_LAS int* tab;
    const int* list;
    __device__ __forceinline__ bool next(int i, Unit& u) const {
        if (!tile_order((long)i * G + c, nM, nN, u.pm, u.pn)) return false;
        const int e = __builtin_amdgcn_readfirstlane(tab[u.pm]);
        u.B = B + (size_t)e * estride + (size_t)u.pn * BM * ldb * 2;
        if (list) { const int j = __builtin_amdgcn_readfirstlane(tab[176 + u.pm]), cnt = __builtin_amdgcn_readfirstlane(tab[352 + e]); u.A = A; u.rows = list + (size_t)e * MT + 256 * j; u.nvalid = cnt - 256 * j; }
        else u.A = A + (size_t)u.pm * BM * lda * 2;
        return true;
    }
};
struct RouterOrder {
    const char* A; const char* B; int nM, G, c;
    __device__ __forceinline__ bool next(int i, Unit& u) const {
        const long L = (long)i * G + c; if (L >= (long)nM * 4) return false;
        u.pm = (int)(L >> 2); u.pn = (int)(L & 3);
        u.A = A + (size_t)u.pm * BM * DM * 2 + (size_t)u.pn * 512 * 2; u.B = B + (size_t)u.pn * 512 * 2; return true;
    }
};
struct S5Order {
    const char* A; const char* B; int lda, ldb, G, c; size_t astride, bstride;
    __device__ __forceinline__ bool next(int i, Unit& u) const {
        const long L = (long)i * G + c; if (L >= 64 * 5) return false;
        u.pn = (int)(L / 5); u.pm = (int)(L % 5);
        u.A = A + (size_t)u.pn * astride + (size_t)u.pm * BM * lda * 2; u.B = B + (size_t)u.pn * bstride; return true;
    }
};

__device__ __forceinline__ unsigned cvt_pk_bf16(float lo, float hi) { unsigned r; asm volatile("v_cvt_pk_bf16_f32 %0, %1, %2" : "=v"(r) : "v"(lo), "v"(hi)); return r; }

template <class Epi, class Sched, bool ALIGN_EPI = false, bool SP2 = false, bool GATHER = false, bool SPLIT = false>
__device__ __forceinline__ void gemm_phase(PG8_LAS unsigned char* lds, const Gemm g, const Sched& S, const Epi& E) {
    const int tid = threadIdx.x, wid = __builtin_amdgcn_readfirstlane(tid >> 6), lane = tid & 63, wr = wid >> 2, wc = wid & 3, fr = lane & 15, fq = lane >> 4;
    int Kop = g.K; asm volatile("" : "+s"(Kop));
    const int K = Kop, nt = K / BK;
    unsigned voffA[2], voffB[2]; int RA[2], CA[2];
#pragma unroll
    for (int i = 0; i < 2; ++i) { int R, C; stage_rc(tid * 16 + i * 8192, R, C); const int Rb = Epi::PERM ? ((R & ~31) + perm32(R & 31)) : R; RA[i] = R; CA[i] = C;
        voffA[i] = (unsigned)(R * g.lda + C) * 2u; voffB[i] = (unsigned)(Rb * g.ldb + C) * 2u; }
    unsigned goffC[2][2], goffN[2][2];
#define PG8_GOFF(dst, u) do { _Pragma("unroll") for (int _h = 0; _h < 2; ++_h) _Pragma("unroll") for (int _i = 0; _i < 2; ++_i) { const int _pos = _h * HALF + RA[_i]; \
        const int _idx = _pos < (u).nvalid ? (u).rows[_pos] : 0; dst[_h][_i] = ((unsigned)_idx * (unsigned)g.lda + (unsigned)CA[_i]) * 2u; } } while (0)
    const size_t kstep = (size_t)(BK * 2);
    const size_t hstepA = (size_t)HALF * g.lda * 2, hstepB = (size_t)HALF * g.ldb * 2;
    const unsigned ldsw = (unsigned)wid * 1024u;
    const int aoff = lds_byte(wr * 64 + fr, fq * 8), boff = lds_byte(wc * 32 + fr, fq * 8);
#define PG8_SA(b, h) (((b) * 2 + (h)) * HTB)
#define PG8_SB(b, h) ((4 + (b) * 2 + (h)) * HTB)
#define PG8_STAGE(bufoff, gbase, voff) do { _Pragma("unroll") for (int _i = 0; _i < 2; ++_i) \
        __builtin_amdgcn_global_load_lds((const unsigned*)((const char*)(gbase) + (voff)[_i]), (PG8_LAS unsigned*)(lds + (bufoff) + ldsw + _i * 8192), 16, 0, 0); } while (0)
#define PG8_STAGE_A(bufoff, usenext, h, ptr, kb) do { if constexpr (GATHER) { _Pragma("unroll") for (int _i = 0; _i < 2; ++_i) { const unsigned _o = (usenext) ? goffN[h][_i] : goffC[h][_i]; \
        __builtin_amdgcn_global_load_lds((const unsigned*)(cA + (kb) + _o), (PG8_LAS unsigned*)(lds + (bufoff) + ldsw + _i * 8192), 16, 0, 0); } } \
        else { PG8_STAGE(bufoff, (ptr) + (h) * hstepA, voffA); } } while (0)
#define PG8_LDA(dst, b, h) do { _Pragma("unroll") for (int m = 0; m < 4; ++m) _Pragma("unroll") for (int k = 0; k < 2; ++k) dst[m][k] = *(const PG8_LAS bf16x8*)(lds + PG8_SA(b, h) + aoff + m * 2048 + k * 1024); } while (0)
#define PG8_LDB(dst, b, h) do { _Pragma("unroll") for (int n = 0; n < 2; ++n) _Pragma("unroll") for (int k = 0; k < 2; ++k) dst[n][k] = *(const PG8_LAS bf16x8*)(lds + PG8_SB(b, h) + boff + n * 2048 + k * 1024); } while (0)
#define PG8_MMA(ai, bj, At, Bt) do { __builtin_amdgcn_s_setprio(1); _Pragma("unroll") for (int m = 0; m < 4; ++m) _Pragma("unroll") for (int n = 0; n < 2; ++n) _Pragma("unroll") for (int k = 0; k < 2; ++k) \
        acc[ai][bj][m][n] = __builtin_amdgcn_mfma_f32_16x16x32_bf16(Bt[n][k], At[m][k], acc[ai][bj][m][n], 0, 0, 0); __builtin_amdgcn_s_setprio(0); } while (0)
#define PG8_MMA2(ai) do { if constexpr (SPLIT) { if (!(cur.skip & (4 << (ai)))) { if (!(cur.skip & 1)) PG8_MMA(ai, 0, At, B0); if (!(cur.skip & 2)) PG8_MMA(ai, 1, At, B1); } } \
        else { PG8_MMA(ai, 0, At, B0); PG8_MMA(ai, 1, At, B1); } } while (0)
#define PG8_WAIT_V(n) asm volatile("s_waitcnt vmcnt(" #n ")" ::: "memory")
#define PG8_WAIT_L(n) asm volatile("s_waitcnt lgkmcnt(" #n ")" ::: "memory")
#define PG8_BAR __builtin_amdgcn_s_barrier()
#define PG8_SCHED __builtin_amdgcn_sched_barrier(0)
    Unit cur, nxt; int ui = 0;
    if (!S.next(0, cur)) return;
    f32x4 acc[2][2][4][2];
#pragma unroll
    for (int a = 0; a < 2; ++a)
#pragma unroll
        for (int b = 0; b < 2; ++b)
#pragma unroll
            for (int m = 0; m < 4; ++m)
#pragma unroll
                for (int n = 0; n < 2; ++n) acc[a][b][m][n] = (f32x4){0.f, 0.f, 0.f, 0.f};
    bf16x8 At[4][2], B0[2][2], B1[2][2];
    const char* cA = cur.A; const char* cB = cur.B;
    if constexpr (GATHER) { PG8_GOFF(goffC, cur); _Pragma("unroll") for (int _h = 0; _h < 2; ++_h) _Pragma("unroll") for (int _i = 0; _i < 2; ++_i) goffN[_h][_i] = goffC[_h][_i]; }
    if constexpr (SP2) {
        PG8_STAGE(PG8_SB(0, 0), cB, voffB); PG8_STAGE(PG8_SB(0, 1), cB + hstepB, voffB); PG8_STAGE_A(PG8_SA(0, 0), false, 0, cA, 0); PG8_STAGE_A(PG8_SA(0, 1), false, 1, cA, 0);
        if (wr == 1) PG8_BAR;
        PG8_WAIT_V(2); PG8_BAR;
        PG8_STAGE(PG8_SB(1, 0), cB + kstep, voffB); PG8_STAGE_A(PG8_SA(1, 0), false, 0, cA + kstep, kstep); PG8_STAGE(PG8_SB(1, 1), cB + hstepB + kstep, voffB);
        PG8_WAIT_V(6); PG8_BAR;
    } else {
        PG8_STAGE(PG8_SB(0, 0), cB, voffB); PG8_STAGE(PG8_SA(0, 0), cA, voffA); PG8_STAGE(PG8_SB(0, 1), cB + hstepB, voffB); PG8_STAGE(PG8_SA(0, 1), cA + hstepA, voffA);
        if (wr == 1) PG8_BAR;
        PG8_WAIT_V(4); PG8_BAR;
        PG8_STAGE(PG8_SB(1, 0), cB + kstep, voffB); PG8_STAGE(PG8_SA(1, 0), cA + kstep, voffA); PG8_STAGE(PG8_SB(1, 1), cB + hstepB + kstep, voffB);
        PG8_WAIT_V(6); PG8_BAR;
    }
    for (;;) {
        const bool has_next = S.next(ui + 1, nxt);
        const char* nA = has_next ? nxt.A : cA; const char* nB = has_next ? nxt.B : cB;
        if constexpr (GATHER) { if (has_next) PG8_GOFF(goffN, nxt); else { _Pragma("unroll") for (int _h = 0; _h < 2; ++_h) _Pragma("unroll") for (int _i = 0; _i < 2; ++_i) goffN[_h][_i] = goffC[_h][_i]; } }
        for (int t = 0; t < nt; t += 2) {
            const bool last = (t == nt - 2);
            const char* a1 = cA + (size_t)(t + 1) * kstep;
            const char* a2 = last ? nA : cA + (size_t)(t + 2) * kstep; const char* b2 = last ? nB : cB + (size_t)(t + 2) * kstep;
            const char* a3 = a2 + kstep; const char* b3 = b2 + kstep;
            if constexpr (SP2) {
            const size_t kb1 = (size_t)(t + 1) * kstep, kb2 = last ? 0 : (size_t)(t + 2) * kstep, kb3 = kb2 + kstep;
            PG8_LDB(B0, 0, 0); PG8_LDB(B1, 0, 1); PG8_SCHED; PG8_LDA(At, 0, 0); PG8_STAGE_A(PG8_SA(1, 1), false, 1, a1, kb1);
            PG8_WAIT_V(8); PG8_WAIT_L(0); PG8_BAR; PG8_MMA2(0); PG8_BAR; PG8_SCHED;
            PG8_LDA(At, 0, 1); PG8_STAGE(PG8_SB(0, 0), b2, voffB); PG8_STAGE(PG8_SB(0, 1), b2 + hstepB, voffB); PG8_STAGE_A(PG8_SA(0, 0), last, 0, a2, kb2);
            PG8_WAIT_V(8); PG8_WAIT_L(0); PG8_BAR; PG8_MMA2(1); PG8_BAR; PG8_SCHED;
            PG8_LDB(B0, 1, 0); PG8_LDB(B1, 1, 1); PG8_SCHED; PG8_LDA(At, 1, 0); PG8_STAGE_A(PG8_SA(0, 1), last, 1, a2, kb2);
            PG8_WAIT_V(8); PG8_WAIT_L(0); PG8_BAR; PG8_MMA2(0); PG8_BAR; PG8_SCHED;
            PG8_LDA(At, 1, 1); PG8_STAGE(PG8_SB(1, 0), b3, voffB); PG8_STAGE(PG8_SB(1, 1), b3 + hstepB, voffB); PG8_STAGE_A(PG8_SA(1, 0), last, 0, a3, kb3);
            PG8_WAIT_V(8); PG8_WAIT_L(0); PG8_BAR; PG8_MMA2(1); PG8_BAR; PG8_SCHED;
            } else {
            PG8_LDB(B0, 0, 0); PG8_SCHED; PG8_LDA(At, 0, 0); PG8_STAGE(PG8_SA(1, 1), a1 + hstepA, voffA);
            PG8_WAIT_L(8); PG8_BAR; PG8_WAIT_L(0); PG8_MMA(0, 0, At, B0); PG8_BAR; PG8_SCHED;
            PG8_LDB(B1, 0, 1); PG8_STAGE(PG8_SB(0, 0), b2, voffB);
            PG8_BAR; PG8_WAIT_L(0); PG8_MMA(0, 1, At, B1); PG8_BAR;
            PG8_LDA(At, 0, 1); PG8_STAGE(PG8_SA(0, 0), a2, voffA);
            PG8_BAR; PG8_WAIT_L(0); PG8_MMA(1, 0, At, B0); PG8_BAR; PG8_SCHED;
            PG8_STAGE(PG8_SB(0, 1), b2 + hstepB, voffB);
            PG8_WAIT_V(6); PG8_BAR; PG8_MMA(1, 1, At, B1); PG8_BAR;
            PG8_LDB(B0, 1, 0); PG8_SCHED; PG8_LDA(At, 1, 0); PG8_STAGE(PG8_SA(0, 1), a2 + hstepA, voffA);
            PG8_WAIT_L(8); PG8_BAR; PG8_WAIT_L(0); PG8_MMA(0, 0, At, B0); PG8_BAR; PG8_SCHED;
            PG8_LDB(B1, 1, 1); PG8_STAGE(PG8_SB(1, 0), b3, voffB);
            PG8_BAR; PG8_WAIT_L(0); PG8_MMA(0, 1, At, B1); PG8_BAR;
            PG8_LDA(At, 1, 1); PG8_STAGE(PG8_SA(1, 0), a3, voffA);
            PG8_BAR; PG8_WAIT_L(0); PG8_MMA(1, 0, At, B0); PG8_BAR; PG8_SCHED;
            PG8_STAGE(PG8_SB(1, 1), b3 + hstepB, voffB);
            PG8_WAIT_V(6); PG8_BAR; PG8_MMA(1, 1, At, B1); PG8_BAR;
            }
        }
        if constexpr (ALIGN_EPI) { if (wr == 0) PG8_BAR; }
        E(acc, cur, wr, wc, fr, fq);
#if PROBE_EPI2
        if constexpr (!Epi::INPLACE) E(acc, cur, wr, wc, fr, fq);
#endif
        if (!has_next) break;
#pragma unroll
        for (int a = 0; a < 2; ++a)
#pragma unroll
            for (int b = 0; b < 2; ++b)
#pragma unroll
                for (int m = 0; m < 4; ++m)
#pragma unroll
                    for (int n = 0; n < 2; ++n) acc[a][b][m][n] = (f32x4){0.f, 0.f, 0.f, 0.f};
        cur = nxt; cA = nA; cB = nB; ++ui;
        if constexpr (GATHER) { _Pragma("unroll") for (int _h = 0; _h < 2; ++_h) _Pragma("unroll") for (int _i = 0; _i < 2; ++_i) goffC[_h][_i] = goffN[_h][_i]; }
        if constexpr (ALIGN_EPI) { if (wr == 1) PG8_BAR; }
    }
    PG8_WAIT_V(0);
    if constexpr (!ALIGN_EPI) { if (wr == 0) PG8_BAR; }
    PG8_BAR;
#undef PG8_SA
#undef PG8_SB
#undef PG8_STAGE
#undef PG8_STAGE_A
#undef PG8_GOFF
#undef PG8_LDA
#undef PG8_LDB
#undef PG8_MMA
#undef PG8_MMA2
#undef PG8_WAIT_V
#undef PG8_WAIT_L
#undef PG8_BAR
#undef PG8_SCHED
}
}

using pg8::Unit; using pg8::cvt_pk_bf16;
#define EPI_LOOP_AM for (int ai = 0; ai < 2; ++ai) _Pragma("unroll") for (int m = 0; m < 4; ++m)
__device__ __forceinline__ u32x4 pack8(const f32x4 v0, const f32x4 v1) { u32x4 w; w.x = cvt_pk_bf16(v0[0], v0[1]); w.y = cvt_pk_bf16(v0[2], v0[3]); w.z = cvt_pk_bf16(v1[0], v1[1]); w.w = cvt_pk_bf16(v1[2], v1[3]); return w; }

template <bool S5NAIVE> struct EpiInProj {
    static constexpr bool PERM = true; static constexpr bool INPLACE = false;
    bf16* u_out; bf16* gq; bf16* gk; bf16* gv; bf16* gr; float* lowr;
    __device__ __forceinline__ void operator()(const f32x4 (&acc)[2][2][4][2], const Unit& u, int wr, int wc, int fr, int fq) const {
#pragma unroll
        EPI_LOOP_AM {
            const int row = u.pm * 256 + ai * 128 + wr * 64 + m * 16 + fr;
            int isctx, b, t; row_decode(row, isctx, b, t);
#pragma unroll
            for (int bj = 0; bj < 2; ++bj) {
                const int c = u.pn * 256 + bj * 128 + wc * 32 + 8 * fq;
                if (u.pn < 16) {
                    const u32x4 w = pack8(acc[ai][bj][m][0], acc[ai][bj][m][1]);
                    bf16* dst;
                    if (u.pn < 4) {
                        if (S5NAIVE) dst = u_out + (size_t)row * 1024 + c;
                        else { const int g = c >> 4, i0 = c & 15, col = b * 272 + (isctx ? 0 : 16) + (t >> 4), tt = t & 15; dst = u_out + ((size_t)(g * S5COLS_PAD + col) * 512 + tt * 16 + i0); }
                    } else if (u.pn < 6) dst = gq + (size_t)row * 512 + (c - 1024);
                    else if (u.pn < 8) dst = gk + (size_t)row * 512 + (c - 1536);
                    else if (u.pn < 12) dst = gv + (size_t)row * 1024 + (c - 2048);
                    else dst = gr + (size_t)row * 1024 + (c - 3072);
                    *(u32x4*)dst = w;
                } else if (bj == 0 && wc == 0) {
                    float* d = lowr + (size_t)row * 32 + 8 * fq;
                    *(f32x4*)d = acc[ai][bj][m][0]; *(f32x4*)(d + 4) = acc[ai][bj][m][1];
                }
            }
        }
    }
};
struct EpiGlu {
    static constexpr bool PERM = true; static constexpr bool INPLACE = false;
    const bf16* G; bf16* AB;
    __device__ __forceinline__ void operator()(const f32x4 (&acc)[2][2][4][2], const Unit& u, int wr, int wc, int fr, int fq) const {
#pragma unroll
        EPI_LOOP_AM {
            const int row = u.pm * 256 + ai * 128 + wr * 64 + m * 16 + fr;
            if (u.skip & (4 << ai)) continue;
#pragma unroll
            for (int bj = 0; bj < 2; ++bj) {
                if (u.skip & (1 << bj)) continue;
                const int c = u.pn * 256 + bj * 128 + wc * 32 + 8 * fq;
                const u32x4 gw = *(const u32x4*)(G + (size_t)row * 1024 + c);
                f32x4 v0 = acc[ai][bj][m][0], v1 = acc[ai][bj][m][1];
                v0[0] = bflo(gw.x) * sigmoid_f(v0[0]); v0[1] = bfhi(gw.x) * sigmoid_f(v0[1]); v0[2] = bflo(gw.y) * sigmoid_f(v0[2]); v0[3] = bfhi(gw.y) * sigmoid_f(v0[3]);
                v1[0] = bflo(gw.z) * sigmoid_f(v1[0]); v1[1] = bfhi(gw.z) * sigmoid_f(v1[1]); v1[2] = bflo(gw.w) * sigmoid_f(v1[2]); v1[3] = bfhi(gw.w) * sigmoid_f(v1[3]);
                *(u32x4*)(AB + (size_t)row * 2048 + c) = pack8(v0, v1);
            }
        }
    }
};
template <bool FROM_INPUT> struct EpiRes {
    static constexpr bool PERM = true; static constexpr bool INPLACE = !FROM_INPUT;
    const float* x; const float* ctx; bf16* XA; const float* gate;
    __device__ __forceinline__ void operator()(const f32x4 (&acc)[2][2][4][2], const Unit& u, int wr, int wc, int fr, int fq) const {
#pragma unroll
        EPI_LOOP_AM {
            const int row = u.pm * 256 + ai * 128 + wr * 64 + m * 16 + fr;
            int isctx, b, t; row_decode(row, isctx, b, t);
            const float* gp = gate + (size_t)(isctx ? 4 : b) * MODW;
            if (u.skip & (4 << ai)) continue;
#pragma unroll
            for (int bj = 0; bj < 2; ++bj) {
                if (u.skip & (1 << bj)) continue;
                const int c = u.pn * 256 + bj * 128 + wc * 32 + 8 * fq;
                f32x4 x0, x1;
                if (FROM_INPUT) { const float* xin = isctx ? ctx + (size_t)(row - NX) * DM : x + (size_t)row * DM; x0 = *(const f32x4*)(xin + c); x1 = *(const f32x4*)(xin + c + 4); }
                else { const u32x4 xw = *(const u32x4*)(XA + (size_t)row * DM + c); x0 = (f32x4){bflo(xw.x), bfhi(xw.x), bflo(xw.y), bfhi(xw.y)}; x1 = (f32x4){bflo(xw.z), bfhi(xw.z), bflo(xw.w), bfhi(xw.w)}; }
                const f32x4 g0 = *(const f32x4*)(gp + c), g1 = *(const f32x4*)(gp + c + 4);
                *(u32x4*)(XA + (size_t)row * DM + c) = pack8(x0 + g0 * acc[ai][bj][m][0], x1 + g1 * acc[ai][bj][m][1]);
            }
        }
    }
};
struct EpiRouter {
    static constexpr bool PERM = false; static constexpr bool INPLACE = false;
    float* LOG;
    __device__ __forceinline__ void operator()(const f32x4 (&acc)[2][2][4][2], const Unit& u, int wr, int wc, int fr, int fq) const {
        if (wc >= 2) return;
#pragma unroll
        EPI_LOOP_AM {
            const int row = u.pm * 256 + ai * 128 + wr * 64 + m * 16 + fr;
#pragma unroll
            for (int n = 0; n < 2; ++n) *(f32x4*)(LOG + ((size_t)u.pn * MT + row) * 64 + wc * 32 + 16 * n + 4 * fq) = acc[ai][0][m][n];
        }
    }
};
struct EpiGU {
    static constexpr bool PERM = true; static constexpr bool INPLACE = false;
    bf16* HH;
    __device__ __forceinline__ void operator()(const f32x4 (&acc)[2][2][4][2], const Unit& u, int wr, int wc, int fr, int fq) const {
#pragma unroll
        EPI_LOOP_AM {
            const int row = u.pm * 256 + ai * 128 + wr * 64 + m * 16 + fr;
            f32x4 v0, v1;
#pragma unroll
            for (int j = 0; j < 4; ++j) { v0[j] = silu_f(acc[ai][0][m][0][j]) * acc[ai][1][m][0][j]; v1[j] = silu_f(acc[ai][0][m][1][j]) * acc[ai][1][m][1][j]; }
            *(u32x4*)(HH + (size_t)row * MOEF + u.pn * 128 + wc * 32 + 8 * fq) = pack8(v0, v1);
        }
    }
};
struct EpiDown {
    static constexpr bool PERM = true; static constexpr bool INPLACE = false;
    bf16* Y; const float* wlist; const LAS int* tab;
    __device__ __forceinline__ void operator()(const f32x4 (&acc)[2][2][4][2], const Unit& u, int wr, int wc, int fr, int fq) const {
        const int e = tab[u.pm], j = tab[176 + u.pm], cnt = tab[352 + e];
#pragma unroll
        EPI_LOOP_AM {
            const int rr = ai * 128 + wr * 64 + m * 16 + fr, row = u.pm * 256 + rr, pos = 256 * j + rr;
            const float w = pos < cnt ? wlist[(size_t)e * MT + pos] : 0.f;
#pragma unroll
            for (int bj = 0; bj < 2; ++bj) {
                const int c = u.pn * 256 + bj * 128 + wc * 32 + 8 * fq;
                *(u32x4*)(Y + (size_t)row * DM + c) = pack8(acc[ai][bj][m][0] * w, acc[ai][bj][m][1] * w);
            }
        }
    }
};
struct EpiQKV {
    static constexpr bool PERM = true; static constexpr bool INPLACE = false;
    bf16* Q; size_t stride;
    __device__ __forceinline__ void operator()(const f32x4 (&acc)[2][2][4][2], const Unit& u, int wr, int wc, int fr, int fq) const {
        bf16* base = Q + (size_t)(u.pn >> 3) * stride; const int ct = (u.pn & 7) * 256;
#pragma unroll
        EPI_LOOP_AM {
            const int row = u.pm * 256 + ai * 128 + wr * 64 + m * 16 + fr;
#pragma unroll
            for (int bj = 0; bj < 2; ++bj) { if ((u.skip & (1 << bj)) || (u.skip & (4 << ai))) continue; *(u32x4*)(base + (size_t)row * DM + ct + bj * 128 + wc * 32 + 8 * fq) = pack8(acc[ai][bj][m][0], acc[ai][bj][m][1]); }
        }
    }
};
struct EpiS5E {
    static constexpr bool PERM = true; static constexpr bool INPLACE = false;
    bf16* LST;
    __device__ __forceinline__ void operator()(const f32x4 (&acc)[2][2][4][2], const Unit& u, int wr, int wc, int fr, int fq) const {
#pragma unroll
        EPI_LOOP_AM {
            const int row = u.pm * 256 + ai * 128 + wr * 64 + m * 16 + fr;
            bf16* d = LST + ((size_t)u.pn * S5COLS_PAD + row) * 256;
#pragma unroll
            for (int bj = 0; bj < 2; ++bj) *(u32x4*)(d + bj * 128 + wc * 32 + 8 * fq) = pack8(acc[ai][bj][m][0], acc[ai][bj][m][1]);
        }
    }
};
struct EpiS5C {
    static constexpr bool PERM = true; static constexpr bool INPLACE = false;
    bf16* G;
    __device__ __forceinline__ void operator()(const f32x4 (&acc)[2][2][4][2], const Unit& u, int wr, int wc, int fr, int fq) const {
#pragma unroll
        EPI_LOOP_AM {
            const int col = u.pm * 256 + ai * 128 + wr * 64 + m * 16 + fr;
            if (col < S5COLS) {
                const int b = col / 272, cidx = col - b * 272;
                const int rowbase = (cidx < 16) ? (NX + b * 256 + 16 * cidx) : (b * 4096 + 16 * (cidx - 16));
#pragma unroll
                for (int bj = 0; bj < 2; ++bj) {
                    const int n0 = bj * 128 + wc * 32 + 8 * fq, tt = n0 >> 4, i0 = n0 & 15;
                    f32x4 v0 = acc[ai][bj][m][0], v1 = acc[ai][bj][m][1];
#pragma unroll
                    for (int j = 0; j < 4; ++j) { v0[j] = gelu_tanh_f(v0[j]); v1[j] = gelu_tanh_f(v1[j]); }
                    *(u32x4*)(G + (size_t)(rowbase + tt) * 1024 + 16 * u.pn + i0) = pack8(v0, v1);
                }
            }
        }
    }
};

#define XB_TMO      128
#define XB_XCNT(j)  (256  + 64 * (j))
#define XB_XSUB(j)  (1280 + 64 * (j))
#define XB_XGEN(j)  (2304 + 64 * (j))
#define XB_TOP      3328
#define XB_TOPGEN   3392
#define XCD_BAR_WORDS 3456
#define XB_SPIN_CAP (1u << 22)
__device__ __forceinline__ unsigned xb_ld(unsigned* p)              { return __hip_atomic_load(p, __ATOMIC_RELAXED, __HIP_MEMORY_SCOPE_AGENT); }
__device__ __forceinline__ unsigned xb_add(unsigned* p, unsigned v) { return __hip_atomic_fetch_add(p, v, __ATOMIC_RELAXED, __HIP_MEMORY_SCOPE_AGENT); }
__device__ __forceinline__ unsigned xb_xcc_id() { return (unsigned)__builtin_amdgcn_s_getreg((3 << 11) | 20) & 0xFu; }
#define XB_SPIN(cond, bar) do { unsigned _sp = 0; while (cond) { __builtin_amdgcn_s_sleep(1); \
    if ((++_sp & 255u) == 0u) { if (xb_ld(&(bar)[XB_TMO])) break; if (_sp > XB_SPIN_CAP) { atomicAdd(&(bar)[XB_TMO], 1u); break; } } } } while (0)
struct XcdBarrier { unsigned* bar; unsigned x; volatile LAS unsigned* st; };
__device__ __forceinline__ XcdBarrier xcd_barrier_post(unsigned* bar, volatile LAS unsigned* st) {
    XcdBarrier b; b.bar = bar; b.x = xb_xcc_id(); b.st = st;
    if (threadIdx.x == 0) (void)xb_add(&bar[XB_XCNT(b.x)], 1u);
    return b;
}
__device__ __forceinline__ void xcd_barrier_complete(unsigned* bar, unsigned x, unsigned& nloc, unsigned& nx) {
    const unsigned G = gridDim.x * gridDim.y * gridDim.z;
    unsigned sum, cnt, mine, sp = 0u;
    for (;;) {
        sum = 0u; cnt = 0u; mine = 0u;
#pragma unroll
        for (unsigned j = 0; j < 16; ++j) { const unsigned c = xb_ld(&bar[XB_XCNT(j)]); sum += c; cnt += (c > 0u) ? 1u : 0u; mine = (j == x) ? c : mine; }
        if (sum == G) break;
        __builtin_amdgcn_s_sleep(1);
        if ((++sp & 255u) == 0u) { if (xb_ld(&bar[XB_TMO])) break; if (sp > XB_SPIN_CAP) { atomicAdd(&bar[XB_TMO], 1u); break; } }
    }
    nloc = mine > 0u ? mine : 1u; nx = cnt > 0u ? cnt : 1u;
}
__device__ __forceinline__ void xcd_barrier(const XcdBarrier& b) {
    asm volatile("s_waitcnt vmcnt(0)" ::: "memory");
    __syncthreads();
    if (threadIdx.x == 0) {
        unsigned* bar = b.bar;
        __builtin_amdgcn_s_waitcnt(0);
        unsigned nloc = b.st[0], nx = b.st[1];
        if (nloc == 0u) { xcd_barrier_complete(bar, b.x, nloc, nx); b.st[0] = nloc; b.st[1] = nx; }
        const unsigned old = xb_add(&bar[XB_XSUB(b.x)], 1u);
        const unsigned gen = old / nloc;
        if (old + 1u == (gen + 1u) * nloc) {
            __builtin_amdgcn_fence(__ATOMIC_RELEASE, "agent");
            asm volatile("s_waitcnt vmcnt(0)" ::: "memory");
            const unsigned og = xb_add(&bar[XB_TOP], 1u);
            const unsigned tg = og / nx;
            if (og + 1u == (tg + 1u) * nx) xb_add(&bar[XB_TOPGEN], 1u);
            else XB_SPIN(xb_ld(&bar[XB_TOPGEN]) == tg, bar);
            __builtin_amdgcn_fence(__ATOMIC_ACQUIRE, "agent");
            xb_add(&bar[XB_XGEN(b.x)], 1u);
            asm volatile("s_waitcnt vmcnt(0)" ::: "memory");
        } else {
            XB_SPIN(xb_ld(&bar[XB_XGEN(b.x)]) == gen, bar);
            __builtin_amdgcn_fence(__ATOMIC_ACQUIRE, "agent");
            asm volatile("s_waitcnt vmcnt(0)" ::: "memory");
        }
    }
    __syncthreads();
}

struct Args { const float* in[32]; float* out; unsigned char* ws; int ph_lo, ph_hi, use_bar, pad; };
enum { I_X = 0, I_C, I_CTX, I_CCTX, I_ADAW, I_ADAB, I_N1G, I_N2G, I_WIN, I_WOUT, I_LRE, I_LIM, I_LDT, I_BRE, I_BIM, I_CRE, I_CIM, I_S5D, I_WGLU,
       I_GW2, I_GBG, I_GNG, I_WQKV, I_WNAO, I_QN, I_KN, I_RPB, I_RG, I_RE, I_MG, I_MU, I_MD };
struct Frame {
    LAS unsigned char* lds; int tid, lane, wave, vcu, G, gw, NGW;
};

__device__ __forceinline__ void transpose_item(const float* W, int ldw, bf16* WT, int ldt, int k0, int n0, int drow0, LAS float* scr, int lane) {
    float tv[32];
#pragma unroll
    for (int i = 0; i < 32; ++i) { const int kk = 2 * i + (lane >> 5); tv[i] = W[(size_t)(k0 + kk) * ldw + n0 + (lane & 31)]; }
#pragma unroll
    for (int i = 0; i < 32; ++i) { const int kk = 2 * i + (lane >> 5); scr[kk * 33 + (lane & 31)] = tv[i]; }
    LDS_WAIT(); asm volatile("" ::: "memory");
    const int c = lane & 7;
#pragma unroll
    for (int j = 0; j < 4; ++j) { const int n = (lane >> 3) + 8 * j; const LAS float* s = scr + (8 * c) * 33 + n;
        u32x4 o; o.x = pk2(s[0 * 33], s[1 * 33]); o.y = pk2(s[2 * 33], s[3 * 33]); o.z = pk2(s[4 * 33], s[5 * 33]); o.w = pk2(s[6 * 33], s[7 * 33]);
        *(u32x4*)(WT + (size_t)(drow0 + n) * ldt + k0 + 8 * c) = o; }
    LDS_WAIT(); asm volatile("" ::: "memory");
}
#ifndef CONV0_Q1
#define CONV0_Q1 800
#define CONV0_Q2 800
#endif
#define CONV0_LATE (CONV0_Q1 + CONV0_Q2)
#ifndef CONV0_MIXA
#define CONV0_INPROJ 200
#define CONV0_PREP 150
#define CONV0_MIXB 150
#define CONV0_MIXA 600
#endif
struct TrItem { const float* W; int ldw; bf16* WT; int ldt, k0, n0, drow0; };
__device__ __forceinline__ TrItem moe_item(const Args& a, int layer, int it) {
    bf16* WGU = (bf16*)(a.ws + WS_WGU); bf16* WD = (bf16*)(a.ws + WS_WD);
    const int e = it / 3072, r = it % 3072; const size_t le = (size_t)layer * NE + e; TrItem t;
    if (r < 2048) {
        const int up = r >> 10, q = r & 1023, pt = q >> 3, kb = 2 * (pt >> 3) + ((q >> 2) & 1), nb = 4 * (pt & 7) + (q & 3), n0 = nb * 32;
        t.W = (up ? a.in[I_MU] : a.in[I_MG]) + le * (size_t)(DM * MOEF); t.ldw = MOEF; t.WT = WGU + (size_t)e * (2048 * 2048); t.ldt = DM; t.k0 = kb * 64; t.n0 = n0; t.drow0 = 256 * (n0 >> 7) + (n0 & 127) + (up ? 128 : 0);
    } else {
        const int q = r - 2048, pt = q >> 3, kb = 2 * (pt >> 4) + ((q >> 2) & 1), nb = 4 * (pt & 15) + (q & 3);
        t.W = a.in[I_MD] + le * (size_t)(MOEF * DM); t.ldw = DM; t.WT = WD + (size_t)e * (2048 * 1024); t.ldt = MOEF; t.k0 = kb * 64; t.n0 = nb * 32; t.drow0 = nb * 32;
    }
    return t;
}
__device__ __forceinline__ void transpose_pair(const TrItem& A, const TrItem& B, bool hasB, LAS float* scrA, LAS float* scrB, int lane) {
    float ta[32], tb[32];
#pragma unroll
    for (int i = 0; i < 32; ++i) { const int kk = 2 * i + (lane >> 5); ta[i] = A.W[(size_t)(A.k0 + kk) * A.ldw + A.n0 + (lane & 31)]; }
#pragma unroll
    for (int i = 0; i < 32; ++i) { const int kk = 2 * i + (lane >> 5); tb[i] = B.W[(size_t)(B.k0 + kk) * B.ldw + B.n0 + (lane & 31)]; }
#pragma unroll
    for (int i = 0; i < 32; ++i) { const int kk = 2 * i + (lane >> 5); scrA[kk * 33 + (lane & 31)] = ta[i]; }
#pragma unroll
    for (int i = 0; i < 32; ++i) { const int kk = 2 * i + (lane >> 5); scrB[kk * 33 + (lane & 31)] = tb[i]; }
    LDS_WAIT(); asm volatile("" ::: "memory");
    const int c = lane & 7;
#pragma unroll
    for (int j = 0; j < 4; ++j) { const int n = (lane >> 3) + 8 * j; const LAS float* s = scrA + (8 * c) * 33 + n;
        u32x4 o; o.x = pk2(s[0 * 33], s[1 * 33]); o.y = pk2(s[2 * 33], s[3 * 33]); o.z = pk2(s[4 * 33], s[5 * 33]); o.w = pk2(s[6 * 33], s[7 * 33]);
        *(u32x4*)(A.WT + (size_t)(A.drow0 + n) * A.ldt + A.k0 + 8 * c) = o; }
    if (hasB) {
#pragma unroll
        for (int j = 0; j < 4; ++j) { const int n = (lane >> 3) + 8 * j; const LAS float* s = scrB + (8 * c) * 33 + n;
            u32x4 o; o.x = pk2(s[0 * 33], s[1 * 33]); o.y = pk2(s[2 * 33], s[3 * 33]); o.z = pk2(s[4 * 33], s[5 * 33]); o.w = pk2(s[6 * 33], s[7 * 33]);
            *(u32x4*)(B.WT + (size_t)(B.drow0 + n) * B.ldt + B.k0 + 8 * c) = o; }
    }
    LDS_WAIT(); asm volatile("" ::: "memory");
}
#ifndef CONV_PAIR
#define CONV_PAIR 1
#endif
#ifndef PROBE_CONV_REPS
#define PROBE_CONV_REPS 1
#endif
__device__ __forceinline__ void moe_convert_items_single(const Args& a, const Frame& F, int layer, int it0, int stride) {
    LAS float* scr = (LAS float*)(F.lds + F.wave * 16896);
    for (int it = it0; it < NE * 3072; it += stride) { const TrItem A = moe_item(a, layer, it); transpose_item(A.W, A.ldw, A.WT, A.ldt, A.k0, A.n0, A.drow0, scr, F.lane); }
}
__device__ __forceinline__ void moe_convert_items_pair(const Args& a, const Frame& F, int layer, int it0, int stride);
__device__ __forceinline__ void moe_convert_items(const Args& a, const Frame& F, int layer, int it0, int stride) {
#pragma nounroll
    for (int rep = 0; rep < PROBE_CONV_REPS; ++rep) { if (CONV_PAIR) moe_convert_items_pair(a, F, layer, it0, stride); else moe_convert_items_single(a, F, layer, it0, stride); }
}
__device__ __forceinline__ void tp_load(const TrItem& A, const TrItem& B, float (&ta)[32], float (&tb)[32], int lane) {
#pragma unroll
    for (int i = 0; i < 32; ++i) { const int kk = 2 * i + (lane >> 5); ta[i] = A.W[(size_t)(A.k0 + kk) * A.ldw + A.n0 + (lane & 31)]; }
#pragma unroll
    for (int i = 0; i < 32; ++i) { const int kk = 2 * i + (lane >> 5); tb[i] = B.W[(size_t)(B.k0 + kk) * B.ldw + B.n0 + (lane & 31)]; }
}
__device__ __forceinline__ void tp_finish(const TrItem& A, const TrItem& B, const float (&ta)[32], const float (&tb)[32], LAS float* scrA, LAS float* scrB, int lane) {
#pragma unroll
    for (int i = 0; i < 32; ++i) { const int kk = 2 * i + (lane >> 5); scrA[kk * 33 + (lane & 31)] = ta[i]; }
#pragma unroll
    for (int i = 0; i < 32; ++i) { const int kk = 2 * i + (lane >> 5); scrB[kk * 33 + (lane & 31)] = tb[i]; }
    LDS_WAIT(); asm volatile("" ::: "memory");
    const int c = lane & 7;
#pragma unroll
    for (int j = 0; j < 4; ++j) { const int n = (lane >> 3) + 8 * j; const LAS float* s = scrA + (8 * c) * 33 + n;
        u32x4 o; o.x = pk2(s[0 * 33], s[1 * 33]); o.y = pk2(s[2 * 33], s[3 * 33]); o.z = pk2(s[4 * 33], s[5 * 33]); o.w = pk2(s[6 * 33], s[7 * 33]);
        *(u32x4*)(A.WT + (size_t)(A.drow0 + n) * A.ldt + A.k0 + 8 * c) = o; }
#pragma unroll
    for (int j = 0; j < 4; ++j) { const int n = (lane >> 3) + 8 * j; const LAS float* s = scrB + (8 * c) * 33 + n;
        u32x4 o; o.x = pk2(s[0 * 33], s[1 * 33]); o.y = pk2(s[2 * 33], s[3 * 33]); o.z = pk2(s[4 * 33], s[5 * 33]); o.w = pk2(s[6 * 33], s[7 * 33]);
        *(u32x4*)(B.WT + (size_t)(B.drow0 + n) * B.ldt + B.k0 + 8 * c) = o; }
    LDS_WAIT(); asm volatile("" ::: "memory");
}
__device__ __forceinline__ void moe_convert_dyn(const Args& a, const Frame& F0, int layer, unsigned* ctr, int base = 0, int NCH = NE * 3072 / 32) {
    Frame F = F0; asm volatile("" : "+v"(F.tid), "+v"(F.lane));
    F.wave = __builtin_amdgcn_readfirstlane(F.tid >> 6);
    LAS float* scrA = (LAS float*)(F.lds + F.wave * 16896); LAS float* scrB = scrA + 64 * 33;
    volatile LAS int* slot = (volatile LAS int*)(F.lds + LDS_MISC) + 20;
    __syncthreads(); if (F.tid == 0) slot[0] = (int)atomicAdd(ctr, 1u); __syncthreads();
    int c = __builtin_amdgcn_readfirstlane(slot[0]), par = 1, nxt = 0;
    if (c < NCH) {
        float r0a[32], r0b[32], r1a[32], r1b[32];
        if (F.tid == 0) nxt = (int)atomicAdd(ctr, 1u);
        { const TrItem A = moe_item(a, layer, (base + c) * 32 + F.wave), B = moe_item(a, layer, (base + c) * 32 + 8 + F.wave); tp_load(A, B, r0a, r0b, F.lane); }
        for (;;) {
            { const TrItem A = moe_item(a, layer, (base + c) * 32 + 16 + F.wave), B = moe_item(a, layer, (base + c) * 32 + 24 + F.wave); tp_load(A, B, r1a, r1b, F.lane); }
            { const TrItem A = moe_item(a, layer, (base + c) * 32 + F.wave), B = moe_item(a, layer, (base + c) * 32 + 8 + F.wave); tp_finish(A, B, r0a, r0b, scrA, scrB, F.lane); }
            if (F.tid == 0) slot[par] = nxt;
            __syncthreads(); const int cn = __builtin_amdgcn_readfirstlane(slot[par]); par ^= 1;
            if (F.tid == 0) nxt = (int)atomicAdd(ctr, 1u);
            if (cn < NCH) { const TrItem A = moe_item(a, layer, (base + cn) * 32 + F.wave), B = moe_item(a, layer, (base + cn) * 32 + 8 + F.wave); tp_load(A, B, r0a, r0b, F.lane); }
            { const TrItem A = moe_item(a, layer, (base + c) * 32 + 16 + F.wave), B = moe_item(a, layer, (base + c) * 32 + 24 + F.wave); tp_finish(A, B, r1a, r1b, scrA, scrB, F.lane); }
            if (cn >= NCH) break;
            c = cn;
        }
    }
    __syncthreads();
}
__device__ __forceinline__ void moe_convert_items_pair(const Args& a, const Frame& F, int layer, int it0, int stride) {
    LAS float* scrA = (LAS float*)(F.lds + F.wave * 16896); LAS float* scrB = scrA + 64 * 33;
    for (int it = it0; it < NE * 3072; it += 2 * stride) {
        const int it2 = it + stride; const bool hasB = it2 < NE * 3072;
        const TrItem A = moe_item(a, layer, it), B = moe_item(a, layer, hasB ? it2 : it);
        transpose_pair(A, B, hasB, scrA, scrB, F.lane);
    }
}
__device__ __forceinline__ void s5_build_consts(const Args& a, const Frame& F);
__device__ __forceinline__ void p0_prologue(const Args& a, const Frame& F) {
    LAS float* scr = (LAS float*)(F.lds + F.wave * 16896);
    constexpr int I_IN = 32 * 129, I_GLU = 16 * 32, I_OUT = 32 * 64, I_QKV = 32 * 192, I_NAO = 32 * 64, NIT = I_IN + I_GLU + I_OUT + I_QKV + I_NAO;
    for (int it = F.gw; it < NIT; it += F.NGW) {
        int r = it;
        if (r < I_IN) { transpose_item(a.in[I_WIN], AB_IN, (bf16*)(a.ws + WS_WIN), DM, (r / 129) * 64, (r % 129) * 32, (r % 129) * 32, scr, F.lane); continue; } r -= I_IN;
        if (r < I_GLU) { transpose_item(a.in[I_WGLU], 1024, (bf16*)(a.ws + WS_WGLU), 1024, (r / 32) * 64, (r % 32) * 32, (r % 32) * 32, scr, F.lane); continue; } r -= I_GLU;
        if (r < I_OUT) { transpose_item(a.in[I_WOUT], DM, (bf16*)(a.ws + WS_WOUT), DM, (r / 64) * 64, (r % 64) * 32, (r % 64) * 32, scr, F.lane); continue; } r -= I_OUT;
        if (r < I_QKV) { transpose_item(a.in[I_WQKV], 3 * DM, (bf16*)(a.ws + WS_WQKV), DM, (r / 192) * 64, (r % 192) * 32, (r % 192) * 32, scr, F.lane); continue; } r -= I_QKV;
        transpose_item(a.in[I_WNAO], DM, (bf16*)(a.ws + WS_WNAO), DM, (r / 64) * 64, (r % 64) * 32, (r % 64) * 32, scr, F.lane);
    }
    for (int i = F.gw * 64 + F.lane; i < 2 * 36 * DM; i += F.NGW * 64) {
        const int l = i / (36 * DM), r = i % (36 * DM), n = r / DM, k = r % DM;
        const float v = n < 4 ? a.in[I_RG][((size_t)l * DM + k) * 4 + n] : a.in[I_RE][((size_t)l * DM + k) * 32 + (n - 4)];
        ((bf16*)(a.ws + WS_WR))[((size_t)l * 256 + n) * DM + k] = (bf16)f2bf(v);
    }
    __syncthreads();
    s5_build_consts(a, F);
    {
        LAS float* sv = (LAS float*)F.lds;
        LAS float* red = (LAS float*)(F.lds + 65536);
#pragma unroll
        for (int it = 0; it < 20; ++it) { const int i = F.tid + 512 * it, r = i / DM, k = i % DM; const float cv = r < 4 ? a.in[I_C][r * DM + k] : a.in[I_CCTX][k]; sv[i] = silu_f(cv); }
        __syncthreads();
        float* MOD = (float*)(a.ws + WS_MOD);
        for (int item = F.vcu; item < 2 * 192; item += F.G) {
            const int l = item / 192, n = (item % 192) * 64 + F.lane;
            const float* W = a.in[I_ADAW] + (size_t)l * DM * MODW + n;
            float acc[5] = {0.f, 0.f, 0.f, 0.f, 0.f};
            for (int j0 = 0; j0 < 256; j0 += 32) {
                float wv[32];
#pragma unroll
                for (int j = 0; j < 32; ++j) wv[j] = W[(size_t)(F.wave + 8 * (j0 + j)) * MODW];
#pragma unroll
                for (int j = 0; j < 32; ++j) { const int k = F.wave + 8 * (j0 + j);
#pragma unroll
                    for (int r = 0; r < 5; ++r) acc[r] += sv[r * DM + k] * wv[j]; }
            }
#pragma unroll
            for (int r = 0; r < 5; ++r) red[(F.wave * 5 + r) * 64 + F.lane] = acc[r];
            __syncthreads();
            if (F.tid < 320) { const int r = F.tid >> 6; float s = a.in[I_ADAB][l * MODW + n];
#pragma unroll
                for (int w = 0; w < 8; ++w) s += red[(w * 5 + r) * 64 + F.lane];
                MOD[((size_t)l * 5 + r) * MODW + n] = s; }
            __syncthreads();
        }
    }
    moe_convert_dyn(a, F, 0, (unsigned*)(a.ws + WS_CTL) + CW_QC0 + 64, CONV0_LATE + CONV0_MIXA + CONV0_INPROJ + CONV0_PREP + CONV0_MIXB, NE * 3072 / 32 - (CONV0_LATE + CONV0_MIXA + CONV0_INPROJ + CONV0_PREP + CONV0_MIXB));
}

__device__ __forceinline__ void modulate_store(const f32x4 (&v)[8], const float* gain, const float* shift, const float* scale, bf16* orow, int lane) {
    float s2 = 0.f;
#pragma unroll
    for (int j = 0; j < 8; ++j) s2 += (v[j].x * v[j].x + v[j].y * v[j].y) + (v[j].z * v[j].z + v[j].w * v[j].w);
    const float rstd = rsqrtf(wave_sum(s2) * (1.f / DM) + EPS);
#pragma unroll
    for (int j = 0; j < 8; ++j) {
        const int c = 4 * lane + 256 * j;
        const f32x4 g = *(const f32x4*)(gain + c), sh = *(const f32x4*)(shift + c), sc = *(const f32x4*)(scale + c);
        const f32x4 y = v[j] * rstd * g * (sc + 1.0f) + sh;
        u32x2 w; w.x = pk2(y.x, y.y); w.y = pk2(y.z, y.w);
        *(u32x2*)(orow + c) = w;
    }
}
__device__ __forceinline__ void modulate_store_lds(const f32x4 (&v)[8], const LAS float* gain, const LAS float* shift, const LAS float* scale, bf16* orow, int lane) {
    float s2 = 0.f;
#pragma unroll
    for (int j = 0; j < 8; ++j) s2 += (v[j].x * v[j].x + v[j].y * v[j].y) + (v[j].z * v[j].z + v[j].w * v[j].w);
    const float rstd = rsqrtf(wave_sum(s2) * (1.f / DM) + EPS);
#pragma unroll
    for (int j = 0; j < 8; ++j) {
        const int c = 4 * lane + 256 * j;
        const f32x4 g = *(const LAS f32x4*)(gain + c), sh = *(const LAS f32x4*)(shift + c), sc = *(const LAS f32x4*)(scale + c);
        const f32x4 y = v[j] * rstd * g * (sc + 1.0f) + sh;
        u32x2 w; w.x = pk2(y.x, y.y); w.y = pk2(y.z, y.w);
        *(u32x2*)(orow + c) = w;
    }
}
__device__ __forceinline__ void stage_mod_lds(LAS float* dst, const float* gain, const float* modrow0, int shift_off, int scale_off, int tid) {
    for (int i = tid; i < DM / 4; i += 512) *(LAS f32x4*)(dst + 4 * i) = *(const f32x4*)(gain + 4 * i);
    for (int i = tid; i < 5 * DM / 4; i += 512) { const int r = i / (DM / 4), c = (i % (DM / 4)) * 4;
        *(LAS f32x4*)(dst + DM + (2 * r) * DM + c) = *(const f32x4*)(modrow0 + (size_t)r * MODW + shift_off + c);
        *(LAS f32x4*)(dst + DM + (2 * r + 1) * DM + c) = *(const f32x4*)(modrow0 + (size_t)r * MODW + scale_off + c); }
}
__device__ __forceinline__ void load_row_bf16(const bf16* p, f32x4 (&v)[8], int lane) {
#pragma unroll
    for (int j = 0; j < 8; ++j) { const u32x2 w = *(const u32x2*)(p + 4 * lane + 256 * j); v[j] = (f32x4){bflo(w.x), bfhi(w.x), bflo(w.y), bfhi(w.y)}; }
}
__device__ __forceinline__ void store_row_bf16(bf16* p, const f32x4 (&v)[8], int lane) {
#pragma unroll
    for (int j = 0; j < 8; ++j) { u32x2 w; w.x = pk2(v[j].x, v[j].y); w.y = pk2(v[j].z, v[j].w); *(u32x2*)(p + 4 * lane + 256 * j) = w; }
}
__device__ __forceinline__ void load_row(const float* p, f32x4 (&v)[8], int lane) {
#pragma unroll
    for (int j = 0; j < 8; ++j) v[j] = *(const f32x4*)(p + 4 * lane + 256 * j);
}

__device__ __forceinline__ float log_sigmoid_f(float z) { return fminf(z, 0.f) - log1pf(__expf(-fabsf(z))); }
__device__ __forceinline__ void gla_prep(const Args& a, const Frame& F) {
    bf16* GQ = (bf16*)(a.ws + WS_GQ); bf16* GK = (bf16*)(a.ws + WS_GK); const float* LOWR = (const float*)(a.ws + WS_LOWR); bf16* LA = (bf16*)(a.ws + WS_LA);
    LAS float* W2s = (LAS float*)F.lds;
    const int lane = F.lane;
    __syncthreads();
#pragma unroll
    for (int it = 0; it < 8; ++it) { const int i = F.tid + 512 * it; *(LAS f32x4*)(W2s + 4 * i) = *(const f32x4*)(a.in[I_GW2] + 4 * i); }
    __syncthreads();
    const float* BG = a.in[I_GBG];
    const int fbase = 8 * (lane & 3); const bool second = (lane & 4) != 0; const int half = (lane & 15) >> 3;
    float inv[8];
#pragma unroll
    for (int j = 0; j < 8; ++j) inv[j] = exp2f(-(float)(fbase + j) * (13.287712379549449f / 32.0f));
    for (int row = F.gw; row < MT; row += F.NGW) {
        int isctx, b, t; row_decode(row, isctx, b, t);
        const u32x4 qw = *(const u32x4*)(GQ + (size_t)row * 512 + 8 * lane), kw = *(const u32x4*)(GK + (size_t)row * 512 + 8 * lane);
        float q[8] = {bflo(qw.x), bfhi(qw.x), bflo(qw.y), bfhi(qw.y), bflo(qw.z), bfhi(qw.z), bflo(qw.w), bfhi(qw.w)};
        float k[8] = {bflo(kw.x), bfhi(kw.x), bflo(kw.y), bfhi(kw.y), bflo(kw.z), bfhi(kw.z), bflo(kw.w), bfhi(kw.w)};
        if (!isctx) {
            const float pos = (float)(half ? (t & 63) : (t >> 6));
#pragma unroll
            for (int j = 0; j < 8; ++j) { const float ang = pos * inv[j], s = __sinf(ang), c = __cosf(ang);
                const float pq = __shfl_xor(q[j], 4), pk = __shfl_xor(k[j], 4);
                q[j] = second ? pq * s + q[j] * c : q[j] * c - pq * s; k[j] = second ? pk * s + k[j] * c : k[j] * c - pk * s; }
        }
        const float qs = 0.08838834764831845f;
        u32x4 qo, ko; qo.x = pk2(q[0] * qs, q[1] * qs); qo.y = pk2(q[2] * qs, q[3] * qs); qo.z = pk2(q[4] * qs, q[5] * qs); qo.w = pk2(q[6] * qs, q[7] * qs);
        ko.x = pk2(k[0], k[1]); ko.y = pk2(k[2], k[3]); ko.z = pk2(k[4], k[5]); ko.w = pk2(k[6], k[7]);
        *(u32x4*)(GQ + (size_t)row * 512 + 8 * lane) = qo; *(u32x4*)(GK + (size_t)row * 512 + 8 * lane) = ko;
#pragma nounroll
        for (int d = 0; d < 2; ++d) {
            f32x4 z0 = *(const f32x4*)(BG + d * 512 + 8 * lane), z1 = *(const f32x4*)(BG + d * 512 + 8 * lane + 4);
#pragma unroll 4
            for (int jj = 0; jj < 16; ++jj) { const float lr = LOWR[(size_t)row * 32 + d * 16 + jj]; const LAS float* w = W2s + (d * 16 + jj) * 512 + 8 * lane;
                z0 += *(const LAS f32x4*)w * lr; z1 += *(const LAS f32x4*)(w + 4) * lr; }
            f32x4 o0, o1;
#pragma unroll
            for (int j = 0; j < 4; ++j) { o0[j] = log_sigmoid_f(z0[j]) * (1.0f / 16.0f); o1[j] = log_sigmoid_f(z1[j]) * (1.0f / 16.0f); }
            *(u32x4*)(LA + ((size_t)d * MT + row) * 512 + 8 * lane) = pack8(o0, o1);
        }
    }
    __syncthreads();
}

__device__ __forceinline__ void s5_naive(const Args& a, const Frame& F) {
    const bf16* GU = (const bf16*)(a.ws + WS_UEXT); float* YD = (float*)(a.ws + WS_YD);
    const int lane = F.lane;
    for (int item = F.gw; item < NB * S5G * 2; item += F.NGW) {
        const int dir = item & 1, g = (item >> 1) & 63, b = item >> 7;
        const size_t po = ((size_t)dir * S5G + g) * S5P + lane;
        const float lr = fminf(a.in[I_LRE][po], -1e-4f), li = a.in[I_LIM][po], dt = expf(a.in[I_LDT][dir * S5G + g]);
        const float mag = expf(lr * dt); float sn, cs; sincosf(li * dt, &sn, &cs);
        const float ar = mag * cs, ai = mag * sn, nr = ar - 1.0f, den = lr * lr + li * li;
        const float fr = (nr * lr + ai * li) / den, fi = (ai * lr - nr * li) / den;
        float btr[16], bti[16], cr[16], ci[16];
#pragma unroll
        for (int j = 0; j < 16; ++j) { const float br = a.in[I_BRE][po * 16 + j], bi = a.in[I_BIM][po * 16 + j]; btr[j] = fr * br - fi * bi; bti[j] = fr * bi + fi * br;
            cr[j] = a.in[I_CRE][(((size_t)dir * S5G + g) * 16 + j) * S5P + lane]; ci[j] = a.in[I_CIM][(((size_t)dir * S5G + g) * 16 + j) * S5P + lane]; }
        float hr = 0.f, hi = 0.f;
        for (int step = 0; step < CTX + SEQ; ++step) {
            int row;
            if (step < CTX) row = NX + b * CTX + (dir ? (CTX - 1 - step) : step);
            else { const int s = step - CTX; row = b * SEQ + (dir ? (SEQ - 1 - s) : s); }
            const u32x4 u0 = *(const u32x4*)(GU + (size_t)row * 1024 + 16 * g), u1 = *(const u32x4*)(GU + (size_t)row * 1024 + 16 * g + 8);
            float uv[16] = {bflo(u0.x), bfhi(u0.x), bflo(u0.y), bfhi(u0.y), bflo(u0.z), bfhi(u0.z), bflo(u0.w), bfhi(u0.w),
                            bflo(u1.x), bfhi(u1.x), bflo(u1.y), bfhi(u1.y), bflo(u1.z), bfhi(u1.z), bflo(u1.w), bfhi(u1.w)};
            float xr = 0.f, xi = 0.f;
#pragma unroll
            for (int j = 0; j < 16; ++j) { xr += btr[j] * uv[j]; xi += bti[j] * uv[j]; }
            const float nhr = ar * hr - ai * hi + xr, nhi = ar * hi + ai * hr + xi; hr = nhr; hi = nhi;
            float yv = 0.f;
#pragma unroll
            for (int i = 0; i < 16; ++i) { const float y = wave_sum(cr[i] * hr - ci[i] * hi); yv = (lane == i) ? y : yv; }
            if (lane < 16) YD[((size_t)dir * MT + row) * 1024 + 16 * g + lane] = yv;
        }
    }
}
__device__ __forceinline__ void s5_finish_naive(const Args& a, const Frame& F) {
    const bf16* GU = (const bf16*)(a.ws + WS_UEXT); const float* YD = (const float*)(a.ws + WS_YD); bf16* G = (bf16*)(a.ws + WS_G);
    for (size_t i = (size_t)F.gw * 64 + F.lane; i < (size_t)MT * 256; i += (size_t)F.NGW * 64) {
        const size_t e = i * 4; const int c = (int)(e & 1023);
        const f32x4 yf = *(const f32x4*)(YD + e), yb = *(const f32x4*)(YD + (size_t)MT * 1024 + e), dk = *(const f32x4*)(a.in[I_S5D] + c);
        const u32x2 uw = *(const u32x2*)(GU + e);
        const float y0 = yf.x + yb.x + dk.x * bflo(uw.x), y1 = yf.y + yb.y + dk.y * bfhi(uw.x), y2 = yf.z + yb.z + dk.z * bflo(uw.y), y3 = yf.w + yb.w + dk.w * bfhi(uw.y);
        u32x2 o; o.x = pk2(gelu_tanh_f(y0), gelu_tanh_f(y1)); o.y = pk2(gelu_tanh_f(y2), gelu_tanh_f(y3));
        *(u32x2*)(G + e) = o;
    }
}


__device__ __forceinline__ void s5_build_consts(const Args& a, const Frame& F) {
    LAS float* pw = (LAS float*)F.lds;
    LAS float* bt = pw + 2 * 64 * 17 * 2;
    LAS float* cc = bt + 2 * 64 * 16 * 2;
    LAS float* Kt = cc + 2 * 16 * 64 * 2;
    bf16* SM = (bf16*)(a.ws + WS_SM); bf16* SE = (bf16*)(a.ws + WS_SE);
    for (int g = F.vcu; g < S5G; g += F.G) {
        __syncthreads();
        if (F.tid < 128) {
            const int dir = F.tid >> 6, p = F.tid & 63; const size_t po = ((size_t)dir * S5G + g) * S5P + p;
            const float lr = fminf(a.in[I_LRE][po], -1e-4f), li = a.in[I_LIM][po], dt = expf(a.in[I_LDT][dir * S5G + g]);
            const float mag = expf(lr * dt); float sn, cs; sincosf(li * dt, &sn, &cs);
            const float ar = mag * cs, ai = mag * sn, nr = ar - 1.0f, den = lr * lr + li * li;
            const float fr = (nr * lr + ai * li) / den, fi = (ai * lr - nr * li) / den;
            for (int n = 0; n <= 16; ++n) { const float m = expf((float)n * lr * dt); float s1, c1; sincosf((float)n * li * dt, &s1, &c1); pw[((dir * 64 + p) * 17 + n) * 2] = m * c1; pw[((dir * 64 + p) * 17 + n) * 2 + 1] = m * s1; }
            for (int j = 0; j < 16; ++j) { const float br = a.in[I_BRE][po * 16 + j], bi = a.in[I_BIM][po * 16 + j]; bt[((dir * 64 + p) * 16 + j) * 2] = fr * br - fi * bi; bt[((dir * 64 + p) * 16 + j) * 2 + 1] = fr * bi + fi * br; }
        }
        for (int i = F.tid; i < 2 * 16 * 64; i += 512) { const int dir = i >> 10, r = i & 1023; const size_t co = ((size_t)dir * S5G + g) * 1024 + r; cc[i * 2] = a.in[I_CRE][co]; cc[i * 2 + 1] = a.in[I_CIM][co]; }
        __syncthreads();
        {
            const int dir = F.tid >> 8, tau = (F.tid >> 4) & 15, i = F.tid & 15;
            float acc[16];
#pragma unroll
            for (int j = 0; j < 16; ++j) acc[j] = 0.f;
            for (int p = 0; p < 64; ++p) {
                const float cr = cc[((dir * 16 + i) * 64 + p) * 2], ci = cc[((dir * 16 + i) * 64 + p) * 2 + 1];
                const float pr = pw[((dir * 64 + p) * 17 + tau) * 2], pi = pw[((dir * 64 + p) * 17 + tau) * 2 + 1];
                const float wr = cr * pr - ci * pi, wi = cr * pi + ci * pr;
#pragma unroll
                for (int j = 0; j < 16; ++j) acc[j] += wr * bt[((dir * 64 + p) * 16 + j) * 2] - wi * bt[((dir * 64 + p) * 16 + j) * 2 + 1];
            }
#pragma unroll
            for (int j = 0; j < 16; ++j) Kt[((dir * 16 + tau) * 16 + i) * 16 + j] = acc[j];
        }
        __syncthreads();
        {
            const int n = F.tid >> 1, half = F.tid & 1, t = n >> 4, i = n & 15;
            bf16* dst = SM + ((size_t)g * 256 + n) * 512 + half * 256;
            for (int k8 = 0; k8 < 32; ++k8) {
                float v[8];
#pragma unroll
                for (int e = 0; e < 8; ++e) {
                    const int k = k8 * 8 + e;
                    if (half == 0) { const int s = k >> 4, j = k & 15;
                        if (s < t) v[e] = Kt[((0 * 16 + (t - s)) * 16 + i) * 16 + j];
                        else if (s > t) v[e] = Kt[((1 * 16 + (s - t)) * 16 + i) * 16 + j];
                        else v[e] = Kt[((0 * 16 + 0) * 16 + i) * 16 + j] + Kt[((1 * 16 + 0) * 16 + i) * 16 + j] + (i == j ? a.in[I_S5D][16 * g + i] : 0.f);
                    } else { const int q = k >> 6, p = k & 63, dir = q >> 1, pn = dir == 0 ? t + 1 : 16 - t;
                        const float cr = cc[((dir * 16 + i) * 64 + p) * 2], ci = cc[((dir * 16 + i) * 64 + p) * 2 + 1];
                        const float pr = pw[((dir * 64 + p) * 17 + pn) * 2], pi = pw[((dir * 64 + p) * 17 + pn) * 2 + 1];
                        v[e] = (q & 1) ? -(cr * pi + ci * pr) : (cr * pr - ci * pi); }
                }
                u32x4 o; o.x = pk2(v[0], v[1]); o.y = pk2(v[2], v[3]); o.z = pk2(v[4], v[5]); o.w = pk2(v[6], v[7]);
                *(u32x4*)(dst + k8 * 8) = o;
            }
        }
        {
            const int n = F.tid >> 1, half = F.tid & 1, q = n >> 6, p = n & 63, dir = q >> 1;
            bf16* dst = SE + ((size_t)g * 256 + n) * 256 + half * 128;
            for (int k8 = 0; k8 < 16; ++k8) {
                float v[8];
#pragma unroll
                for (int e = 0; e < 8; ++e) {
                    const int k = half * 128 + k8 * 8 + e, s = k >> 4, j = k & 15, pn = dir == 0 ? 15 - s : s;
                    const float pr = pw[((dir * 64 + p) * 17 + pn) * 2], pi = pw[((dir * 64 + p) * 17 + pn) * 2 + 1];
                    const float br = bt[((dir * 64 + p) * 16 + j) * 2], bi = bt[((dir * 64 + p) * 16 + j) * 2 + 1];
                    v[e] = (q & 1) ? (pr * bi + pi * br) : (pr * br - pi * bi);
                }
                u32x4 o; o.x = pk2(v[0], v[1]); o.y = pk2(v[2], v[3]); o.z = pk2(v[4], v[5]); o.w = pk2(v[6], v[7]);
                *(u32x4*)(dst + k8 * 8) = o;
            }
        }
    }
    __syncthreads();
}
__device__ __forceinline__ void s5_scan(const Args& a, const Frame& F) {
    const bf16* LST = (const bf16*)(a.ws + WS_LST); bf16* UEXT = (bf16*)(a.ws + WS_UEXT);
    for (int item = F.gw; item < S5G * NB * 2; item += F.NGW) {
        const int dir = item & 1, b = (item >> 1) & 3, g = item >> 3, p = F.lane;
        const size_t po = ((size_t)dir * S5G + g) * S5P + p;
        const float lr = fminf(a.in[I_LRE][po], -1e-4f), li = a.in[I_LIM][po], dt = expf(a.in[I_LDT][dir * S5G + g]);
        const float mag = expf(16.0f * lr * dt); float sn, cs; sincosf(16.0f * li * dt, &sn, &cs);
        const float ar = mag * cs, ai = mag * sn;
        float hr = 0.f, hi = 0.f;
        const size_t colbase = (size_t)g * S5COLS_PAD + b * 272;
        for (int c0 = 0; c0 < 272; c0 += 16) {
            float lre[16], lim[16];
#pragma unroll
            for (int j = 0; j < 16; ++j) { const int c = c0 + j, cidx = dir == 0 ? c : (c < 16 ? 15 - c : 287 - c);
                const bf16* lp = LST + (colbase + cidx) * 256 + dir * 128 + p; lre[j] = bf2f(lp[0]); lim[j] = bf2f(lp[64]); }
#pragma unroll
            for (int j = 0; j < 16; ++j) { const int c = c0 + j, cidx = dir == 0 ? c : (c < 16 ? 15 - c : 287 - c);
                bf16* up = UEXT + (colbase + cidx) * 512 + 256 + dir * 128 + p;
                up[0] = (bf16)f2bf(hr); up[64] = (bf16)f2bf(hi);
                const float nhr = ar * hr - ai * hi + lre[j], nhi = ar * hi + ai * hr + lim[j]; hr = nhr; hi = nhi; }
        }
    }
}

__device__ __forceinline__ void gla_naive(const Args& a, const Frame& F) {
    const bf16* GQ = (const bf16*)(a.ws + WS_GQ); const bf16* GK = (const bf16*)(a.ws + WS_GK); const bf16* GV = (const bf16*)(a.ws + WS_GV);
    const float* LA = (const float*)(a.ws + WS_LA); float* OD = (float*)(a.ws + WS_UC);
    LAS float* red = (LAS float*)F.lds;
    const int e = F.tid & 31, dg = F.tid >> 5;
    for (int item = F.vcu; item < NB * GH * 2 * 8; item += F.G) {
        const int es = item & 7, dir = (item >> 3) & 1, h = (item >> 4) & 3, b = item >> 6;
        float S[8];
#pragma unroll
        for (int j = 0; j < 8; ++j) S[j] = 0.f;
        int prow = -1;
        for (int step = 0; step < CTX + SEQ; ++step) {
            int row;
            if (step < CTX) row = NX + b * CTX + (dir ? (CTX - 1 - step) : step);
            else { const int s = step - CTX; row = b * SEQ + (dir ? (SEQ - 1 - s) : s); }
            const size_t qo = (size_t)row * 512 + h * 128 + dg * 8;
            const u32x4 qw = *(const u32x4*)(GQ + qo), kw = *(const u32x4*)(GK + qo);
            const f32x4 la0 = *(const f32x4*)(LA + ((size_t)dir * MT + row) * 512 + h * 128 + dg * 8), la1 = *(const f32x4*)(LA + ((size_t)dir * MT + row) * 512 + h * 128 + dg * 8 + 4);
            const float v = bf2f(GV[(size_t)row * 1024 + h * 256 + es * 32 + e]);
            const float qv[8] = {bflo(qw.x), bfhi(qw.x), bflo(qw.y), bfhi(qw.y), bflo(qw.z), bfhi(qw.z), bflo(qw.w), bfhi(qw.w)};
            const float kv[8] = {bflo(kw.x), bfhi(kw.x), bflo(kw.y), bfhi(kw.y), bflo(kw.z), bfhi(kw.z), bflo(kw.w), bfhi(kw.w)};
            const float lv[8] = {la0.x, la0.y, la0.z, la0.w, la1.x, la1.y, la1.z, la1.w};
            float part = 0.f;
#pragma unroll
            for (int j = 0; j < 8; ++j) { S[j] = __expf(lv[j]) * S[j] + kv[j] * v; part += qv[j] * S[j]; }
            red[((step & 1) * 16 + dg) * 32 + e] = part;
            __syncthreads();
            if (F.tid < 32) { float o = 0.f;
#pragma unroll
                for (int w = 0; w < 16; ++w) o += red[((step & 1) * 16 + w) * 32 + e];
                OD[((size_t)dir * MT + row) * 1024 + h * 256 + es * 32 + e] = o; }
            (void)prow;
        }
        __syncthreads();
    }
}
__device__ __forceinline__ void gla_finish_naive(const Args& a, const Frame& F) {
    const float* OD = (const float*)(a.ws + WS_UC); const bf16* GR = (const bf16*)(a.ws + WS_GR); bf16* AB = (bf16*)(a.ws + WS_AB);
    for (int item = F.gw; item < MT * GH; item += F.NGW) {
        const int row = item >> 2, h = item & 3; const size_t o = (size_t)row * 1024 + h * 256 + 4 * F.lane;
        const f32x4 v = *(const f32x4*)(OD + o) + *(const f32x4*)(OD + (size_t)MT * 1024 + o);
        const float rstd = rsqrtf(wave_sum((v.x * v.x + v.y * v.y) + (v.z * v.z + v.w * v.w)) * (1.f / 256.f) + EPS);
        const f32x4 g = *(const f32x4*)(a.in[I_GNG] + h * 256 + 4 * F.lane); const u32x2 rw = *(const u32x2*)(GR + o);
        u32x2 w; w.x = pk2(v.x * rstd * g.x * silu_f(bflo(rw.x)), v.y * rstd * g.y * silu_f(bfhi(rw.x))); w.y = pk2(v.z * rstd * g.z * silu_f(bflo(rw.y)), v.w * rstd * g.w * silu_f(bfhi(rw.y)));
        *(u32x2*)(AB + (size_t)row * 2048 + 1024 + h * 256 + 4 * F.lane) = w;
    }
}


__device__ __forceinline__ float scan_incl(float v, int lane, bool suffix) {
#pragma unroll
    for (int o = 1; o < 64; o <<= 1) { const float u = suffix ? __shfl_down(v, o) : __shfl_up(v, o); const bool ok = suffix ? (lane + o < 64) : (lane >= o); v += ok ? u : 0.f; }
    return v;
}
template <int CTRL, int ROWMASK, bool BOUND> __device__ __forceinline__ float dpp_mov0(float x) {
    return __builtin_bit_cast(float, __builtin_amdgcn_update_dpp(0, __builtin_bit_cast(int, x), CTRL, ROWMASK, 0xF, BOUND)); }
__device__ __forceinline__ float prefix_incl_dpp(float v) {
    v += dpp_mov0<0x111, 0xF, true>(v); v += dpp_mov0<0x112, 0xF, true>(v); v += dpp_mov0<0x114, 0xF, true>(v); v += dpp_mov0<0x118, 0xF, true>(v);
    v += dpp_mov0<0x142, 0xA, false>(v);
    v += dpp_mov0<0x143, 0xC, false>(v);
    return v;
}
__device__ __forceinline__ float lane_bcast(float x, int srclane);
template <int N, bool SUFFIX> __device__ __forceinline__ void scan_vec(float (&v)[N], int lane) {
#pragma unroll
    for (int j = 0; j < N; ++j) { const float x = v[j], p = prefix_incl_dpp(x); v[j] = SUFFIX ? (lane_bcast(p, 63) - p) + x : p; }
}
__device__ __forceinline__ float lane_bcast(float x, int srclane) { return __builtin_bit_cast(float, __builtin_amdgcn_readlane(__builtin_bit_cast(int, x), srclane)); }
__device__ __forceinline__ int gla_rowbase(int b, int cidx) { return cidx < 4 ? NX + b * CTX + cidx * 64 : b * SEQ + (cidx - 4) * 64; }
__device__ __forceinline__ void gla_pass_a(const Args& a, const Frame& F) {
    const bf16* GK = (const bf16*)(a.ws + WS_GK); const bf16* GV = (const bf16*)(a.ws + WS_GV); const bf16* LA = (const bf16*)(a.ws + WS_LA);
    bf16* UC = (bf16*)(a.ws + WS_UC); float* DEC = (float*)(a.ws + WS_DEC);
    constexpr int TP = 144; typedef short v4i16_t __attribute__((ext_vector_type(4)));
    LAS unsigned char* Vt = F.lds; LAS unsigned char* KoT = F.lds + 256 * TP;
    const int lane = F.lane, w = F.wave, r32 = lane & 31, hh = lane >> 5;
    for (int item = F.vcu; item < 2176; item += F.G) {
        const int cidx = item % 68, dir = (item / 68) & 1, h = (item / 136) & 3, b = item / 544;
        const size_t row = (size_t)gla_rowbase(b, cidx) + lane;
        __syncthreads();
        {
            const int vt = F.tid >> 3, vc = F.tid & 7;
            const u32x4* src = (const u32x4*)(GV + ((size_t)gla_rowbase(b, cidx) + vt) * 1024 + h * 256 + 32 * vc);
#pragma unroll
            for (int q = 0; q < 4; ++q) *(LAS u32x4*)(Vt + vt * 576 + vc * 64 + 16 * q) = src[q];
        }
        {
            const bf16* lp = LA + ((size_t)dir * MT + row) * 512 + h * 128 + 16 * w;
            const u32x4* kp = (const u32x4*)(GK + row * 512 + h * 128 + 16 * w);
            const u32x4 k0 = kp[0], k1 = kp[1];
            const unsigned kw[8] = {k0.x, k0.y, k0.z, k0.w, k1.x, k1.y, k1.z, k1.w};
            const u32x4 l0 = *(const u32x4*)lp, l1 = *(const u32x4*)(lp + 8);
            float bc[16] = {bflo(l0.x), bfhi(l0.x), bflo(l0.y), bfhi(l0.y), bflo(l0.z), bfhi(l0.z), bflo(l0.w), bfhi(l0.w), bflo(l1.x), bfhi(l1.x), bflo(l1.y), bfhi(l1.y), bflo(l1.z), bfhi(l1.z), bflo(l1.w), bfhi(l1.w)};
            if (dir) scan_vec<16, true>(bc, lane); else scan_vec<16, false>(bc, lane);
#pragma unroll
            for (int j = 0; j < 16; ++j) {
                const float blast = dir ? lane_bcast(bc[j], 0) : lane_bcast(bc[j], 63);
                const float kv = (j & 1) ? bfhi(kw[j >> 1]) : bflo(kw[j >> 1]);
                *(LAS unsigned short*)(KoT + (16 * w + j) * TP + lane * 2) = (unsigned short)f2bf(kv * __expf(blast - bc[j]));
                if (lane == 0) DEC[(size_t)item * 128 + 16 * w + j] = __expf(blast); }
        }
        __syncthreads();
        f32x16 acc[4];
#pragma unroll
        for (int dt = 0; dt < 4; ++dt)
#pragma unroll
            for (int r = 0; r < 16; ++r) acc[dt][r] = 0.f;
#pragma unroll
        for (int ks = 0; ks < 4; ++ks) { const LAS unsigned char* vp = Vt + (16 * ks + 8 * hh + ((lane & 15) >> 2)) * 576 + (32 * w + 16 * ((lane >> 4) & 1) + 4 * (lane & 3)) * 2;
            const u32x2 alo = __builtin_bit_cast(u32x2, __builtin_amdgcn_ds_read_tr16_b64_v4i16((LAS v4i16_t*)vp)), ahi = __builtin_bit_cast(u32x2, __builtin_amdgcn_ds_read_tr16_b64_v4i16((LAS v4i16_t*)(vp + 4 * 576)));
            const bf16x8 af = __builtin_bit_cast(bf16x8, (u32x4){alo.x, alo.y, ahi.x, ahi.y});
#pragma unroll
            for (int dt = 0; dt < 4; ++dt) { const bf16x8 bf = *(const LAS bf16x8*)(KoT + (32 * dt + r32) * TP + (16 * ks + 8 * hh) * 2); acc[dt] = __builtin_amdgcn_mfma_f32_32x32x16_bf16(af, bf, acc[dt], 0, 0, 0); } }
        LAS unsigned char* ot = F.lds + 256 * TP + 128 * TP + w * (32 * 272);
#pragma unroll
        for (int dt = 0; dt < 4; ++dt)
#pragma unroll
            for (int r = 0; r < 16; ++r) *(LAS unsigned short*)(ot + ((r & 3) + 8 * (r >> 2) + 4 * hh) * 272 + (32 * dt + r32) * 2) = (unsigned short)f2bf(acc[dt][r]);
        bf16* out = UC + ((size_t)item * 256 + 32 * w) * 128;
#pragma unroll
        for (int i = 0; i < 8; ++i) { const int rr = (lane >> 4) + 4 * i, ch = lane & 15;
            *(u32x4*)(out + (size_t)rr * 128 + 8 * ch) = *(const LAS u32x4*)(ot + rr * 272 + ch * 16); }
    }
    __syncthreads();
}
__device__ __forceinline__ void gla_scan(const Args& a, const Frame& F) {
    bf16* UC = (bf16*)(a.ws + WS_UC); const float* DEC = (const float*)(a.ws + WS_DEC);
    for (int ch = F.gw * 64 + F.lane; ch < 32 * 256 * 16; ch += F.NGW * 64) {
        const int d8 = ch & 15, e = (ch >> 4) & 255, seq = ch >> 12, dir = seq & 1;
        float S[8];
#pragma unroll
        for (int j = 0; j < 8; ++j) S[j] = 0.f;
#pragma unroll 4
        for (int c = 0; c < 68; ++c) {
            const int cidx = dir == 0 ? c : (c < 4 ? 3 - c : 71 - c);
            const size_t item = (size_t)seq * 68 + cidx;
            u32x4* p = (u32x4*)(UC + (item * 256 + e) * 128 + 8 * d8);
            const f32x4 dc0 = *(const f32x4*)(DEC + item * 128 + 8 * d8), dc1 = *(const f32x4*)(DEC + item * 128 + 8 * d8 + 4);
            const u32x4 t = *p;
            u32x4 o; o.x = pg8::cvt_pk_bf16(S[0], S[1]); o.y = pg8::cvt_pk_bf16(S[2], S[3]); o.z = pg8::cvt_pk_bf16(S[4], S[5]); o.w = pg8::cvt_pk_bf16(S[6], S[7]);
            *p = o;
            S[0] = dc0.x * S[0] + bflo(t.x); S[1] = dc0.y * S[1] + bfhi(t.x); S[2] = dc0.z * S[2] + bflo(t.y); S[3] = dc0.w * S[3] + bfhi(t.y);
            S[4] = dc1.x * S[4] + bflo(t.z); S[5] = dc1.y * S[5] + bfhi(t.z); S[6] = dc1.z * S[6] + bflo(t.w); S[7] = dc1.w * S[7] + bfhi(t.w);
        }
    }
}
__device__ __forceinline__ void gla_pass_c(const Args& a, const Frame& F) {
    const bf16* GQ = (const bf16*)(a.ws + WS_GQ); const bf16* GK = (const bf16*)(a.ws + WS_GK); const bf16* GV = (const bf16*)(a.ws + WS_GV); const bf16* GR = (const bf16*)(a.ws + WS_GR);
    const bf16* LA = (const bf16*)(a.ws + WS_LA); const bf16* UC = (const bf16*)(a.ws + WS_UC); bf16* AB = (bf16*)(a.ws + WS_AB);
    constexpr int QP = 528, TP = 144, OP = 1040; typedef short v4i16_t __attribute__((ext_vector_type(4)));
    LAS unsigned char* Qc = F.lds; LAS unsigned char* Kc = F.lds + 64 * QP; LAS unsigned char* Pl = F.lds + 128 * QP; LAS unsigned char* Vt = Pl + 64 * TP; LAS unsigned char* Of = F.lds;
    const int lane = F.lane, w = F.wave, r32 = lane & 31, hh = lane >> 5, tid = F.tid;
    for (int item = F.vcu; item < 1088; item += F.G) {
        const int cidx = item % 68, h = (item / 68) & 3, b = item / 272;
        const int rowbase = gla_rowbase(b, cidx);
        const size_t row = (size_t)rowbase + lane;
        const size_t itf = ((size_t)(b * 4 + h) * 2) * 68 + cidx, itb = itf + 68;
        bf16x8 sb[16];
#pragma unroll
        for (int ks = 0; ks < 16; ++ks) sb[ks] = *(const bf16x8*)(UC + (((ks >> 3) ? itb : itf) * 256 + 32 * w + r32) * 128 + 16 * (ks & 7) + 8 * hh);
        u32x2 rwp[8];
        { const int t_ = tid >> 3, part_ = tid & 7;
#pragma unroll
            for (int i = 0; i < 8; ++i) rwp[i] = *(const u32x2*)(GR + ((size_t)rowbase + t_) * 1024 + h * 256 + 4 * part_ + 32 * i); }
        __syncthreads();
        {
            const int vt = tid >> 3, vc = tid & 7;
            const u32x4* src = (const u32x4*)(GV + ((size_t)rowbase + vt) * 1024 + h * 256 + 32 * vc);
#pragma unroll
            for (int q = 0; q < 4; ++q) *(LAS u32x4*)(Vt + vt * 576 + vc * 64 + 16 * q) = src[q];
        }
        {
            const bf16* lf = LA + row * 512 + h * 128 + 16 * w; const bf16* lb = lf + (size_t)MT * 512;
            const u32x4* qp = (const u32x4*)(GQ + row * 512 + h * 128 + 16 * w); const u32x4* kp = (const u32x4*)(GK + row * 512 + h * 128 + 16 * w);
            const u32x4 q0 = qp[0], q1 = qp[1], k0 = kp[0], k1 = kp[1];
            const unsigned qw[8] = {q0.x, q0.y, q0.z, q0.w, q1.x, q1.y, q1.z, q1.w}, kw[8] = {k0.x, k0.y, k0.z, k0.w, k1.x, k1.y, k1.z, k1.w};
            const u32x4 f0 = *(const u32x4*)lf, f1 = *(const u32x4*)(lf + 8), b0 = *(const u32x4*)lb, b1 = *(const u32x4*)(lb + 8);
            float bf[16] = {bflo(f0.x), bfhi(f0.x), bflo(f0.y), bfhi(f0.y), bflo(f0.z), bfhi(f0.z), bflo(f0.w), bfhi(f0.w), bflo(f1.x), bfhi(f1.x), bflo(f1.y), bfhi(f1.y), bflo(f1.z), bfhi(f1.z), bflo(f1.w), bfhi(f1.w)};
            float bb[16] = {bflo(b0.x), bfhi(b0.x), bflo(b0.y), bfhi(b0.y), bflo(b0.z), bfhi(b0.z), bflo(b0.w), bfhi(b0.w), bflo(b1.x), bfhi(b1.x), bflo(b1.y), bfhi(b1.y), bflo(b1.z), bfhi(b1.z), bflo(b1.w), bfhi(b1.w)};
            scan_vec<16, false>(bf, lane); scan_vec<16, true>(bb, lane);
            unsigned oqf[8], oqb[8], okf[8], okb[8];
#pragma unroll
            for (int p = 0; p < 8; ++p) {
                const float qa = bflo(qw[p]), qb2 = bfhi(qw[p]), ka = bflo(kw[p]), kb2 = bfhi(kw[p]);
                const float efa = __expf(bf[2 * p]), efb = __expf(bf[2 * p + 1]), eba = __expf(bb[2 * p]), ebb = __expf(bb[2 * p + 1]);
                oqf[p] = pk2(qa * efa, qb2 * efb); oqb[p] = pk2(qa * eba, qb2 * ebb);
                okf[p] = pk2(ka * __builtin_amdgcn_rcpf(efa), kb2 * __builtin_amdgcn_rcpf(efb)); okb[p] = pk2(ka * __builtin_amdgcn_rcpf(eba), kb2 * __builtin_amdgcn_rcpf(ebb));
            }
            LAS unsigned char* qd = Qc + lane * QP + 32 * w; LAS unsigned char* kd = Kc + lane * QP + 32 * w;
            *(LAS u32x4*)qd = (u32x4){oqf[0], oqf[1], oqf[2], oqf[3]}; *(LAS u32x4*)(qd + 16) = (u32x4){oqf[4], oqf[5], oqf[6], oqf[7]};
            *(LAS u32x4*)(qd + 256) = (u32x4){oqb[0], oqb[1], oqb[2], oqb[3]}; *(LAS u32x4*)(qd + 272) = (u32x4){oqb[4], oqb[5], oqb[6], oqb[7]};
            *(LAS u32x4*)kd = (u32x4){okf[0], okf[1], okf[2], okf[3]}; *(LAS u32x4*)(kd + 16) = (u32x4){okf[4], okf[5], okf[6], okf[7]};
            *(LAS u32x4*)(kd + 256) = (u32x4){okb[0], okb[1], okb[2], okb[3]}; *(LAS u32x4*)(kd + 272) = (u32x4){okb[4], okb[5], okb[6], okb[7]};
        }
        __syncthreads();
        if (w < 4) {
            const int ti = w >> 1, si = w & 1;
            f32x16 af, ab;
#pragma unroll
            for (int r = 0; r < 16; ++r) { af[r] = 0.f; ab[r] = 0.f; }
            if (si <= ti) {
#pragma unroll
                for (int ks = 0; ks < 8; ++ks) { const bf16x8 x = *(const LAS bf16x8*)(Qc + (32 * ti + r32) * QP + (16 * ks + 8 * hh) * 2), y = *(const LAS bf16x8*)(Kc + (32 * si + r32) * QP + (16 * ks + 8 * hh) * 2); af = __builtin_amdgcn_mfma_f32_32x32x16_bf16(x, y, af, 0, 0, 0); } }
            if (si >= ti) {
#pragma unroll
                for (int ks = 8; ks < 16; ++ks) { const bf16x8 x = *(const LAS bf16x8*)(Qc + (32 * ti + r32) * QP + (16 * ks + 8 * hh) * 2), y = *(const LAS bf16x8*)(Kc + (32 * si + r32) * QP + (16 * ks + 8 * hh) * 2); ab = __builtin_amdgcn_mfma_f32_32x32x16_bf16(x, y, ab, 0, 0, 0); } }
#pragma unroll
            for (int r = 0; r < 16; ++r) { const int t = 32 * ti + (r & 3) + 8 * (r >> 2) + 4 * hh, s = 32 * si + r32;
                const float v = (s <= t ? af[r] : 0.f) + (s >= t ? ab[r] : 0.f);
                *(LAS unsigned short*)(Pl + t * TP + s * 2) = (unsigned short)f2bf(v); }
        }
        __syncthreads();
        f32x16 o[2];
#pragma unroll
        for (int tt = 0; tt < 2; ++tt)
#pragma unroll
            for (int r = 0; r < 16; ++r) o[tt][r] = 0.f;
#pragma unroll
        for (int ks = 0; ks < 4; ++ks) { const LAS unsigned char* vp = Vt + (16 * ks + 8 * hh + ((lane & 15) >> 2)) * 576 + (32 * w + 16 * ((lane >> 4) & 1) + 4 * (lane & 3)) * 2;
            const u32x2 vlo = __builtin_bit_cast(u32x2, __builtin_amdgcn_ds_read_tr16_b64_v4i16((LAS v4i16_t*)vp)), vhi = __builtin_bit_cast(u32x2, __builtin_amdgcn_ds_read_tr16_b64_v4i16((LAS v4i16_t*)(vp + 4 * 576)));
            const bf16x8 vb = __builtin_bit_cast(bf16x8, (u32x4){vlo.x, vlo.y, vhi.x, vhi.y});
#pragma unroll
            for (int tt = 0; tt < 2; ++tt) { const bf16x8 pa = *(const LAS bf16x8*)(Pl + (32 * tt + r32) * TP + (16 * ks + 8 * hh) * 2); o[tt] = __builtin_amdgcn_mfma_f32_32x32x16_bf16(pa, vb, o[tt], 0, 0, 0); } }
#pragma unroll
        for (int kg = 0; kg < 4; ++kg) {
            bf16x8 qa[4][2];
#pragma unroll
            for (int k4 = 0; k4 < 4; ++k4)
#pragma unroll
                for (int tt = 0; tt < 2; ++tt) qa[k4][tt] = *(const LAS bf16x8*)(Qc + (32 * tt + r32) * QP + (16 * (4 * kg + k4) + 8 * hh) * 2);
            __builtin_amdgcn_sched_barrier(0);
#pragma unroll
            for (int k4 = 0; k4 < 4; ++k4)
#pragma unroll
                for (int tt = 0; tt < 2; ++tt) o[tt] = __builtin_amdgcn_mfma_f32_32x32x16_bf16(qa[k4][tt], sb[4 * kg + k4], o[tt], 0, 0, 0);
        }
        __syncthreads();
#pragma unroll
        for (int tt = 0; tt < 2; ++tt)
#pragma unroll
            for (int r = 0; r < 16; ++r) *(LAS float*)(Of + (32 * tt + (r & 3) + 8 * (r >> 2) + 4 * hh) * OP + (32 * w + r32) * 4) = o[tt][r];
        __syncthreads();
        {
            const int t = tid >> 3, part = tid & 7; const size_t orow = (size_t)rowbase + t;
            f32x4 v[8]; float ss = 0.f;
#pragma unroll
            for (int i = 0; i < 8; ++i) { v[i] = *(const LAS f32x4*)(Of + t * OP + (4 * part + 32 * i) * 4); ss += (v[i].x * v[i].x + v[i].y * v[i].y) + (v[i].z * v[i].z + v[i].w * v[i].w); }
            ss += __shfl_xor(ss, 1); ss += __shfl_xor(ss, 2); ss += __shfl_xor(ss, 4);
            const float rstd = rsqrtf(ss * (1.f / 256.f) + EPS);
#pragma unroll
            for (int i = 0; i < 8; ++i) { const int e = 4 * part + 32 * i;
                const f32x4 g = *(const f32x4*)(a.in[I_GNG] + h * 256 + e); const u32x2 rw = rwp[i];
                u32x2 ow; ow.x = pk2(v[i].x * rstd * g.x * silu_f(bflo(rw.x)), v[i].y * rstd * g.y * silu_f(bfhi(rw.x))); ow.y = pk2(v[i].z * rstd * g.z * silu_f(bflo(rw.y)), v[i].w * rstd * g.w * silu_f(bfhi(rw.y)));
                *(u32x2*)(AB + orow * 2048 + 1024 + h * 256 + e) = ow; }
        }
    }
    __syncthreads();
}

__device__ __forceinline__ void moe_route(const Args& a, const Frame& F, int nrows, unsigned* cnt) {
    const float* LOG = (const float*)(a.ws + WS_LOG); int* ROUTE = (int*)(a.ws + WS_ROUTE);
    for (int row = F.gw * 64 + F.lane; row < nrows; row += F.NGW * 64) {
        float lgv[36];
#pragma unroll
        for (int q = 0; q < 9; ++q) { f32x4 s = *(const f32x4*)(LOG + (size_t)row * 64 + 4 * q);
#pragma unroll
            for (int ksl = 1; ksl < 4; ++ksl) s += *(const f32x4*)(LOG + ((size_t)ksl * MT + row) * 64 + 4 * q);
            lgv[4 * q] = s.x; lgv[4 * q + 1] = s.y; lgv[4 * q + 2] = s.z; lgv[4 * q + 3] = s.w; }
        const f32x4 gl = {lgv[0], lgv[1], lgv[2], lgv[3]};
        int gi = 0; float gm = gl.x; if (gl.y > gm) { gm = gl.y; gi = 1; } if (gl.z > gm) { gm = gl.z; gi = 2; } if (gl.w > gm) { gm = gl.w; gi = 3; }
        const float ptop = 1.0f / (expf(gl.x - gm) + expf(gl.y - gm) + expf(gl.z - gm) + expf(gl.w - gm));
        float ev[8];
#pragma unroll
        for (int j = 0; j < 8; ++j) { const float c0 = gi & 1 ? lgv[12 + j] : lgv[4 + j], c1 = gi & 1 ? lgv[28 + j] : lgv[20 + j]; ev[j] = gi & 2 ? c1 : c0; }
        int i0 = 0; float v0 = ev[0];
#pragma unroll
        for (int j = 1; j < 8; ++j) if (ev[j] > v0) { v0 = ev[j]; i0 = j; }
        int i1 = -1; float v1 = -3.0e38f;
#pragma unroll
        for (int j = 0; j < 8; ++j) if (j != i0 && ev[j] > v1) { v1 = ev[j]; i1 = j; }
        const float t = expf(v1 - v0), w0 = ptop / (1.0f + t), w1 = ptop * t / (1.0f + t);
        const int x0 = gi * 8 + i0, x1 = gi * 8 + i1;
        const int s0 = (int)atomicAdd(cnt + x0, 1u), s1 = (int)atomicAdd(cnt + x1, 1u);
        int* r = ROUTE + (size_t)row * 8;
        r[0] = x0; r[1] = x1; r[2] = s0; r[3] = s1;
        int* LIST = (int*)(a.ws + WS_LIST); float* WLIST = (float*)(a.ws + WS_WLIST);
        LIST[(size_t)x0 * MT + s0] = row; LIST[(size_t)x1 * MT + s1] = row; WLIST[(size_t)x0 * MT + s0] = w0; WLIST[(size_t)x1 * MT + s1] = w1;
    }
}
__device__ __forceinline__ int moe_tables(const Frame& F, const unsigned* cnt) {
    LAS int* tab = (LAS int*)(F.lds + LDS_TAB);
    __syncthreads();
    if (F.tid < NE) tab[352 + F.tid] = (int)__hip_atomic_load(cnt + F.tid, __ATOMIC_RELAXED, __HIP_MEMORY_SCOPE_AGENT);
    __syncthreads();
    if (F.tid == 0) { int p = 0;
        for (int e = 0; e < NE; ++e) { const int c = tab[352 + e]; tab[384 + e] = p; const int nt = (c + 255) >> 8;
            for (int j = 0; j < nt; ++j) { tab[(p >> 8) + j] = e; tab[176 + (p >> 8) + j] = j; } p += nt << 8; }
        tab[384 + NE] = p; }
    __syncthreads();
    return tab[384 + NE] >> 8;
}
__device__ __forceinline__ void moe_combine_row(const Args& a, const LAS int* pstart, const LAS float* g2s, int row, int l, f32x4 (&v)[8], int lane) {
    const int* r = (const int*)(a.ws + WS_ROUTE) + (size_t)row * 8; const int d0 = pstart[r[0]] + r[2], d1 = pstart[r[1]] + r[3];
    const bf16* Y = (const bf16*)(a.ws + WS_Y); const bf16* XA = (const bf16*)(a.ws + WS_XA);
    int isctx, b, t; row_decode(row, isctx, b, t);
    const LAS float* g2 = g2s + (isctx ? 4 : b) * DM;
#pragma unroll
    for (int j = 0; j < 8; ++j) {
        const int c = 4 * lane + 256 * j;
        const u32x2 y0 = *(const u32x2*)(Y + (size_t)d0 * DM + c), y1 = *(const u32x2*)(Y + (size_t)d1 * DM + c);
        const u32x2 xw = *(const u32x2*)(XA + (size_t)row * DM + c); const f32x4 xv = {bflo(xw.x), bfhi(xw.x), bflo(xw.y), bfhi(xw.y)}, g = *(const LAS f32x4*)(g2 + c);
        f32x4 y; y.x = bflo(y0.x) + bflo(y1.x); y.y = bfhi(y0.x) + bfhi(y1.x); y.z = bflo(y0.y) + bflo(y1.y); y.w = bfhi(y0.y) + bfhi(y1.y);
        v[j] = xv + g * y;
    }
}

__device__ __forceinline__ void qk_norm(const Args& a, const Frame& F) {
    bf16* Q = (bf16*)(a.ws + WS_Q); bf16* K = (bf16*)(a.ws + WS_K);
    const float qsc = 0.08838834764831845f * 1.4426950408889634f;
    for (int item0 = F.gw; item0 < MT * 4; item0 += 4 * F.NGW) {
        u32x4 w[4]; bf16* base[4];
#pragma unroll
        for (int u = 0; u < 4; ++u) { const int item = min(item0 + u * F.NGW, MT * 4 - 1), row = item >> 2, part = 4 + (item & 3);
            base[u] = (part < 4 ? Q : K) + (size_t)row * DM + (part & 3) * 512 + 8 * F.lane; w[u] = *(const u32x4*)base[u]; }
#pragma unroll
        for (int u = 0; u < 4; ++u) {
            const int item = item0 + u * F.NGW; if (item >= MT * 4) break;
            const int part = 4 + (item & 3); const float* nw = (part < 4 ? a.in[I_QN] : a.in[I_KN]) + 8 * (F.lane & 15);
            float v[8] = {bflo(w[u].x), bfhi(w[u].x), bflo(w[u].y), bfhi(w[u].y), bflo(w[u].z), bfhi(w[u].z), bflo(w[u].w), bfhi(w[u].w)};
            float s = 0.f;
#pragma unroll
            for (int j = 0; j < 8; ++j) s += v[j] * v[j];
            s += __shfl_xor(s, 1); s += __shfl_xor(s, 2); s += __shfl_xor(s, 4); s += __shfl_xor(s, 8);
            const float rstd = rsqrtf(s * (1.f / 128.f) + EPS) * (part < 4 ? qsc : 1.0f);
            u32x4 o; o.x = pk2(v[0] * rstd * nw[0], v[1] * rstd * nw[1]); o.y = pk2(v[2] * rstd * nw[2], v[3] * rstd * nw[3]); o.z = pk2(v[4] * rstd * nw[4], v[5] * rstd * nw[5]); o.w = pk2(v[6] * rstd * nw[6], v[7] * rstd * nw[7]);
            *(u32x4*)base[u] = o;
        }
    }
}

__device__ __forceinline__ void na_naive(const Args& a, const Frame& F) {
    const bf16* Q = (const bf16*)(a.ws + WS_Q); const bf16* K = (const bf16*)(a.ws + WS_K); const bf16* V = (const bf16*)(a.ws + WS_V); bf16* O = (bf16*)(a.ws + WS_O);
    LAS float* qs = (LAS float*)(F.lds + F.wave * 4096);
    LAS float* ps = qs + 128;
    const float* RPB = a.in[I_RPB];
    const int lane = F.lane;
    for (int item = F.gw; item < NX * NAH; item += F.NGW) {
        const int tok = item >> 4, h = item & 15, b = tok >> 12, t = tok & 4095, r = t >> 6, qc = t & 63;
        const int start = min(max(r - 4, 0), 56), cs = min(max(qc - 8, 0), 48);
        { const unsigned w = *(const unsigned*)(Q + (size_t)tok * DM + h * 128 + 2 * lane); qs[2 * lane] = bflo(w); qs[2 * lane + 1] = bfhi(w); }
        LDS_WAIT();
        float s[6]; float mx = -3.0e38f;
#pragma unroll
        for (int i = 0; i < 6; ++i) {
            const int j = lane + 64 * i; size_t krow; float bias = 0.f;
            if (j < 128) { const int kr = j >> 4, kc = cs + (j & 15); krow = (size_t)b * SEQ + (start + kr) * 64 + kc; bias = RPB[((size_t)h * 15 + (start + kr - r + 7)) * 31 + (kc - qc + 15)] * 1.4426950408889634f; }
            else krow = (size_t)NX + b * CTX + (j - 128);
            const u32x4* kp = (const u32x4*)(K + krow * DM + h * 128);
            float dot = 0.f;
#pragma unroll
            for (int c = 0; c < 16; ++c) { const u32x4 kw = kp[c]; const f32x4 qa = *(const LAS f32x4*)(qs + 8 * c), qb = *(const LAS f32x4*)(qs + 8 * c + 4);
                dot += bflo(kw.x) * qa.x + bfhi(kw.x) * qa.y + bflo(kw.y) * qa.z + bfhi(kw.y) * qa.w + bflo(kw.z) * qb.x + bfhi(kw.z) * qb.y + bflo(kw.w) * qb.z + bfhi(kw.w) * qb.w; }
            s[i] = dot + bias; mx = fmaxf(mx, s[i]);
        }
        mx = wave_max(mx);
        float l = 0.f;
#pragma unroll
        for (int i = 0; i < 6; ++i) { const float p = exp2f(s[i] - mx); l += p; ps[lane + 64 * i] = p; }
        l = wave_sum(l);
        LDS_WAIT();
        float o0 = 0.f, o1 = 0.f;
        for (int j = 0; j < 384; ++j) {
            size_t vrow;
            if (j < 128) vrow = (size_t)b * SEQ + (start + (j >> 4)) * 64 + cs + (j & 15); else vrow = (size_t)NX + b * CTX + (j - 128);
            const unsigned w = *(const unsigned*)(V + vrow * DM + h * 128 + 2 * lane); const float p = ps[j];
            o0 += p * bflo(w); o1 += p * bfhi(w);
        }
        const float il = 1.0f / l;
        *(unsigned*)(O + (size_t)tok * DM + h * 128 + 2 * lane) = pk2(o0 * il, o1 * il);
    }
}


#ifndef K_NORM_IN_NA
#define K_NORM_IN_NA 1
#endif
template <bool DYN>
__device__ __forceinline__ void na_fast(const Args& a, const Frame& F, unsigned* qctr, int qbase, int qend) {
    const bf16* Q = (const bf16*)(a.ws + WS_Q); const bf16* K = (const bf16*)(a.ws + WS_K); const bf16* V = (const bf16*)(a.ws + WS_V); bf16* O = (bf16*)(a.ws + WS_O);
    constexpr int KP = 272, VP = 320, BUFB = 64 * KP + 64 * VP;
    typedef short v4i16_t __attribute__((ext_vector_type(4)));
    LAS unsigned char* rp2 = F.lds + 2 * BUFB;
    LAS float* gq = (LAS float*)(rp2 + 2048);
    const float* RPB = a.in[I_RPB];
    const int lane = F.lane, r32 = lane & 31, hh = lane >> 5, w = F.wave, tid = F.tid;
    const int skey = tid >> 3, sch = tid & 7;
    volatile LAS int* slot = (volatile LAS int*)(F.lds + LDS_MISC) + 16;
    int item = F.vcu; const int iend = DYN ? qend : NB * NAH * 16;
    if (DYN) { __syncthreads(); if (tid == 0) slot[0] = qbase + (int)atomicAdd(qctr, 1u); __syncthreads(); item = __builtin_amdgcn_readfirstlane(slot[0]); }
    while (item < iend) {
        const int rg = item & 15, h = (item >> 4) & 15, b = item >> 8;
        const int qr = rg * 4 + (w >> 1), qc = 32 * (w & 1) + r32;
        const size_t tok = (size_t)b * SEQ + qr * 64 + qc;
        const int start = min(max(qr - 4, 0), 56), cs = min(max(qc - 8, 0), 48);
        const int kr_lo = min(max(rg * 4 - 4, 0), 56), kr_hi = min(max(rg * 4 - 1, 0), 56) + 7, nblk = 4 + (kr_hi - kr_lo + 1);
        bf16x8 qf[8];
#pragma unroll
        for (int ks = 0; ks < 8; ++ks) qf[ks] = *(const bf16x8*)(Q + tok * DM + h * 128 + 16 * ks + 8 * hh);
        unsigned boffp[8];
#pragma unroll
        for (int wd = 0; wd < 8; ++wd) { unsigned pk = 0;
#pragma unroll
            for (int j = 0; j < 4; ++j) { const int kt = wd >> 2, r = 4 * (wd & 3) + j, kc = 32 * kt + (r & 3) + 8 * (r >> 2) + 4 * hh; pk |= (unsigned)(((unsigned)(kc - cs) < 16u) ? (kc - qc + 15) * 4 : 31 * 4) << (8 * j); }
            boffp[wd] = pk; }
        u32x4 kg0, kg1, vg0, vg1;
#define NA_LOAD(nb_) do { const int nb__ = (nb_); const size_t rowbase = nb__ < 4 ? (size_t)NX + b * CTX + nb__ * 64 : (size_t)b * SEQ + (kr_lo + nb__ - 4) * 64; \
            const u32x4* ksrc = (const u32x4*)(K + (rowbase + skey) * DM + h * 128 + 16 * sch); kg0 = ksrc[0]; kg1 = ksrc[1]; \
            const u32x4* vsrc = (const u32x4*)(V + (rowbase + skey) * DM + h * 128 + 16 * sch); vg0 = vsrc[0]; vg1 = vsrc[1]; } while (0)
#define NA_KSQ(w_) ((bflo(w_.x) * bflo(w_.x) + bfhi(w_.x) * bfhi(w_.x)) + (bflo(w_.y) * bflo(w_.y) + bfhi(w_.y) * bfhi(w_.y)) + (bflo(w_.z) * bflo(w_.z) + bfhi(w_.z) * bfhi(w_.z)) + (bflo(w_.w) * bflo(w_.w) + bfhi(w_.w) * bfhi(w_.w)))
#define NA_KSC(w_, r_) do { w_.x = pg8::cvt_pk_bf16(bflo(w_.x) * r_, bfhi(w_.x) * r_); w_.y = pg8::cvt_pk_bf16(bflo(w_.y) * r_, bfhi(w_.y) * r_); w_.z = pg8::cvt_pk_bf16(bflo(w_.z) * r_, bfhi(w_.z) * r_); w_.w = pg8::cvt_pk_bf16(bflo(w_.w) * r_, bfhi(w_.w) * r_); } while (0)
#define NA_STAGE(buf_) do { LAS unsigned char* Ks_ = F.lds + (buf_) * BUFB; LAS unsigned char* Vt_ = Ks_ + 64 * KP; \
            if (K_NORM_IN_NA) { float ss_ = NA_KSQ(kg0) + NA_KSQ(kg1);       \
                ss_ += dpp_mov0<0xB1, 0xF, true>(ss_); ss_ += dpp_mov0<0x4E, 0xF, true>(ss_); ss_ += dpp_mov0<0x141, 0xF, true>(ss_); \
                const float rk_ = rsqrtf(ss_ * (1.f / 128.f) + EPS); NA_KSC(kg0, rk_); NA_KSC(kg1, rk_); } \
            *(LAS u32x4*)(Ks_ + skey * KP + sch * 32) = kg0; *(LAS u32x4*)(Ks_ + skey * KP + sch * 32 + 16) = kg1; \
            *(LAS u32x4*)(Vt_ + skey * VP + sch * 32) = vg0; *(LAS u32x4*)(Vt_ + skey * VP + sch * 32 + 16) = vg1; } while (0)
        int nxt = 0;
        if (DYN && tid == 0) nxt = qbase + (int)atomicAdd(qctr, 1u);
        NA_LOAD(0);
        __syncthreads();
        for (int i = tid; i < 15 * 32; i += 512) { const int dr = i >> 5, c = i & 31; *(LAS float*)(rp2 + i * 4) = c < 31 ? RPB[h * 465 + dr * 31 + c] * 1.4426950408889634f : -1.0e30f; }
        if (tid < 128) gq[tid] = a.in[I_QN][tid] * (K_NORM_IN_NA ? a.in[I_KN][tid] : 1.0f);
        NA_STAGE(0);
        if (DYN && tid == 0) slot[0] = nxt;
        NA_LOAD(1);
        __syncthreads();
        {
            float ss = 0.f;
#pragma unroll
            for (int ks = 0; ks < 8; ++ks) { const u32x4 qw = __builtin_bit_cast(u32x4, qf[ks]);
                ss += (bflo(qw.x) * bflo(qw.x) + bfhi(qw.x) * bfhi(qw.x)) + (bflo(qw.y) * bflo(qw.y) + bfhi(qw.y) * bfhi(qw.y)) + (bflo(qw.z) * bflo(qw.z) + bfhi(qw.z) * bfhi(qw.z)) + (bflo(qw.w) * bflo(qw.w) + bfhi(qw.w) * bfhi(qw.w)); }
            ss += __shfl_xor(ss, 32);
            const float rstd = rsqrtf(ss * (1.f / 128.f) + EPS) * (0.08838834764831845f * 1.4426950408889634f);
#pragma unroll
            for (int ks = 0; ks < 8; ++ks) { const u32x4 qw = __builtin_bit_cast(u32x4, qf[ks]);
                const f32x4 n0 = *(const LAS f32x4*)(gq + 16 * ks + 8 * hh), n1 = *(const LAS f32x4*)(gq + 16 * ks + 8 * hh + 4);
                u32x4 o; o.x = pk2(bflo(qw.x) * rstd * n0.x, bfhi(qw.x) * rstd * n0.y); o.y = pk2(bflo(qw.y) * rstd * n0.z, bfhi(qw.y) * rstd * n0.w);
                o.z = pk2(bflo(qw.z) * rstd * n1.x, bfhi(qw.z) * rstd * n1.y); o.w = pk2(bflo(qw.w) * rstd * n1.z, bfhi(qw.w) * rstd * n1.w);
                qf[ks] = __builtin_bit_cast(bf16x8, o); }
        }
        f32x16 ot[4];
#pragma unroll
        for (int dt = 0; dt < 4; ++dt)
#pragma unroll
            for (int r = 0; r < 16; ++r) ot[dt][r] = 0.f;
        float m = 0.f, l = 0.f;
#define NA_BODY(BUF) do { \
            const int krow = blk < 4 ? -1 : kr_lo + blk - 4; \
            const LAS unsigned char* Ks = F.lds + (BUF) * BUFB; const LAS unsigned char* Vt = Ks + 64 * KP; \
            const bool mine = blk < 4 || (krow >= start && krow < start + 8); \
            if (blk + 1 < nblk) NA_STAGE(1 - (BUF)); \
            if (blk + 2 < nblk) NA_LOAD(blk + 2); \
            if (mine) { \
                const LAS unsigned char* brow = rp2 + (krow - qr + 7) * 128; \
_Pragma("unroll") \
                for (int kt = 0; kt < 2; ++kt) { \
                    f32x16 st; bf16x8 kfr[8]; \
                    if (blk >= 4) { _Pragma("unroll") for (int r = 0; r < 16; ++r) st[r] = *(const LAS float*)(brow + ((boffp[kt * 4 + (r >> 2)] >> (8 * (r & 3))) & 0xffu)) - m; } \
                    else { _Pragma("unroll") for (int r = 0; r < 16; ++r) st[r] = -m; } \
_Pragma("unroll") \
                    for (int ks = 0; ks < 8; ++ks) kfr[ks] = *(const LAS bf16x8*)(Ks + (32 * kt + r32) * KP + (16 * ks + 8 * hh) * 2); \
                    __builtin_amdgcn_sched_barrier(0); \
                    __builtin_amdgcn_s_setprio(1); \
_Pragma("unroll") \
                    for (int ks = 0; ks < 8; ++ks) st = __builtin_amdgcn_mfma_f32_32x32x16_bf16(kfr[ks], qf[ks], st, 0, 0, 0); \
                    __builtin_amdgcn_s_setprio(0); \
                    float tmax = -3.0e38f; \
_Pragma("unroll") \
                    for (int r = 0; r < 16; ++r) tmax = fmaxf(tmax, st[r]); \
                    tmax = fmaxf(tmax, __shfl_xor(tmax, 32)); \
                    float alpha = 1.0f; \
                    const bool first = (blk == 0) && (kt == 0);        \
                    const bool resc = first || !__all(tmax <= 8.0f); \
                    if (resc) { const float dm = first ? tmax : fmaxf(tmax, 0.f); alpha = first ? 1.0f : __builtin_amdgcn_exp2f(-dm); m += dm; \
_Pragma("unroll") \
                        for (int r = 0; r < 16; ++r) st[r] -= dm; } \
                    float psum = 0.f; unsigned pw[8]; \
_Pragma("unroll") \
                    for (int r = 0; r < 16; r += 2) { const float p0 = __builtin_amdgcn_exp2f(st[r]), p1 = __builtin_amdgcn_exp2f(st[r + 1]); psum += p0 + p1; pw[r >> 1] = pg8::cvt_pk_bf16(p0, p1); } \
                    l = l * alpha + psum; \
                    if (resc) { \
_Pragma("unroll") \
                        for (int dt = 0; dt < 4; ++dt) \
_Pragma("unroll") \
                            for (int r = 0; r < 16; ++r) ot[dt][r] *= alpha; \
                    } \
_Pragma("unroll") \
                    for (int s2 = 0; s2 < 2; ++s2) { \
                        const u32x4 pbw = {pw[4 * s2], pw[4 * s2 + 1], pw[4 * s2 + 2], pw[4 * s2 + 3]}; \
                        const bf16x8 pb = __builtin_bit_cast(bf16x8, pbw); \
_Pragma("unroll") \
                        for (int dt = 0; dt < 4; ++dt) { \
                            const LAS unsigned char* vp = Vt + (32 * kt + 16 * s2 + 4 * hh + ((lane & 15) >> 2)) * VP + (32 * dt + 16 * ((lane >> 4) & 1) + 4 * (lane & 3)) * 2; \
                            const u32x2 lo = __builtin_bit_cast(u32x2, __builtin_amdgcn_ds_read_tr16_b64_v4i16((LAS v4i16_t*)vp)), hi = __builtin_bit_cast(u32x2, __builtin_amdgcn_ds_read_tr16_b64_v4i16((LAS v4i16_t*)(vp + 8 * VP))); \
                            const u32x4 vw = {lo.x, lo.y, hi.x, hi.y}; \
                            ot[dt] = __builtin_amdgcn_mfma_f32_32x32x16_bf16(__builtin_bit_cast(bf16x8, vw), pb, ot[dt], 0, 0, 0); \
                        } \
                    } \
                } \
            } \
            __syncthreads(); \
        } while (0)
        for (int blk = 0; blk < nblk; ) { NA_BODY(0); if (++blk >= nblk) break; NA_BODY(1); ++blk; }
#undef NA_BODY
#undef NA_LOAD
#undef NA_STAGE
#undef NA_KSQ
#undef NA_KSC
        const float il = 1.0f / (l + __shfl_xor(l, 32));
#pragma unroll
        for (int dt = 0; dt < 4; ++dt)
#pragma unroll
            for (int g4 = 0; g4 < 4; ++g4) {
                u32x2 o; o.x = pg8::cvt_pk_bf16(ot[dt][4 * g4] * il, ot[dt][4 * g4 + 1] * il); o.y = pg8::cvt_pk_bf16(ot[dt][4 * g4 + 2] * il, ot[dt][4 * g4 + 3] * il);
                *(u32x2*)(O + tok * DM + h * 128 + 32 * dt + 8 * g4 + 4 * hh) = o;
            }
        if (DYN) item = __builtin_amdgcn_readfirstlane(slot[0]); else item += F.G;
    }
    __syncthreads();
}

#ifndef S5_NAIVE
#define S5_NAIVE 0
#endif
#ifndef GLA_NAIVE
#define GLA_NAIVE 0
#endif
#ifndef NA_NAIVE
#define NA_NAIVE 0
#endif
#ifndef NA_CONV_OVERLAP
#define NA_CONV_OVERLAP 1
#endif
#ifndef K_NORM_IN_NA
#define K_NORM_IN_NA 1
#endif
#ifndef NA_CONV_FIRST_Q
#define NA_CONV_FIRST_Q 2
#endif
#ifndef PROBE_REPEAT_MASK
#define PROBE_REPEAT_MASK 0u
#endif
#ifndef PROBE_EPI2
#define PROBE_EPI2 0
#endif
#ifndef PROBE_SUB
#define PROBE_SUB 0
#endif
#define SUBREP(id) _Pragma("nounroll") for (int srep_ = 0; srep_ < ((PROBE_SUB) == (id) ? 3 : 1); ++srep_)
#ifndef MK_PER_PHASE
#define MK_PER_PHASE 0
#endif
enum { PH_PRO = 0, PH_MOD1, PH_INPROJ, PH_PREP, PH_MIXA, PH_MIXB, PH_MIXC, PH_OUT, PH_MOD2_L0, PH_ROUTER_L0, PH_ROUTE_L0, PH_GU_L0, PH_DOWN_L0, PH_COMB_L0,
       PH_QKV, PH_QKNORM, PH_NA, PH_NAO, PH_MOD2_L1, PH_ROUTER_L1, PH_ROUTE_L1, PH_GU_L1, PH_DOWN_L1, PH_COMB_L1, NPH };

__global__ void __launch_bounds__(512, 2) fwd_kernel(Args args) {
    extern __shared__ __attribute__((aligned(16))) unsigned char lds_raw[];
    Frame F;
    F.lds = (LAS unsigned char*)lds_raw;
    F.tid = threadIdx.x; F.lane = F.tid & 63; F.wave = __builtin_amdgcn_readfirstlane(F.tid >> 6);
    F.G = gridDim.x; { const int bx = blockIdx.x; F.vcu = (F.G % 8 == 0) ? (bx % 8) * (F.G / 8) + bx / 8 : bx; }
    F.gw = F.vcu * 8 + F.wave; F.NGW = F.G * 8;
    volatile LAS unsigned* MISC = (volatile LAS unsigned*)(F.lds + LDS_MISC);
    unsigned char* ws = args.ws;
    gu32* ctl = (gu32*)(ws + WS_CTL);
    for (int u = F.tid; u < (LDS_BYTES - LDS_MISC) / 4; u += 512) ((LAS unsigned*)(F.lds + LDS_MISC))[u] = 0u;
    __syncthreads();
    XcdBarrier bar; bar.bar = (unsigned*)ctl + CW_BAR; bar.x = 0; bar.st = nullptr;
    if (args.use_bar) bar = xcd_barrier_post((unsigned*)ctl + CW_BAR, MISC + 8);
    const int lo = args.ph_lo, hi = args.ph_hi;
#define IN(k) (lo <= (k) && (k) < hi)
#define REPS(k) _Pragma("unroll") for (int rep_ = 0; rep_ < (int)(((PROBE_REPEAT_MASK) >> (k)) & 1u) + 1; ++rep_)
#define SEAM(k) do { if (IN(k) && IN((k) + 1)) xcd_barrier(bar); } while (0)
    LAS unsigned char* ring = F.lds;
    float* MOD = (float*)(ws + WS_MOD);
    bf16* H = (bf16*)(ws + WS_H); bf16* XA = (bf16*)(ws + WS_XA);
    const int bid = (int)blockIdx.x;
    const int rpb = (MT + F.G - 1) / F.G, rb0 = F.vcu * rpb, rb1 = min(MT, rb0 + rpb);

    if (IN(PH_PRO)) REPS(PH_PRO) { p0_prologue(args, F); }
    SEAM(PH_PRO);
    if (IN(PH_MOD1)) REPS(PH_MOD1) {
        LAS float* mods = (LAS float*)F.lds;
        __syncthreads(); stage_mod_lds(mods, args.in[I_N1G], MOD, 0, DM, F.tid); __syncthreads();
        for (int row = rb0 + F.wave; row < rb1; row += 16) {
            const int row2 = row + 8; const bool has2 = row2 < rb1;
            int isctx, b, t, isctx2, b2, t2; row_decode(row, isctx, b, t); row_decode(has2 ? row2 : row, isctx2, b2, t2);
            const float* xin = isctx ? args.in[I_CTX] + (size_t)(row - NX) * DM : args.in[I_X] + (size_t)row * DM;
            const float* xin2 = isctx2 ? args.in[I_CTX] + (size_t)((has2 ? row2 : row) - NX) * DM : args.in[I_X] + (size_t)(has2 ? row2 : row) * DM;
            const float* mr = MOD + (size_t)(isctx ? 4 : b) * MODW; const float* mr2 = MOD + (size_t)(isctx2 ? 4 : b2) * MODW;
            f32x4 v[8], v2[8]; load_row(xin, v, F.lane); load_row(xin2, v2, F.lane);
            const int mi = isctx ? 4 : b, mi2 = isctx2 ? 4 : b2;
            modulate_store_lds(v, mods, mods + DM + 2 * mi * DM, mods + DM + (2 * mi + 1) * DM, H + (size_t)row * DM, F.lane);
            if (has2) modulate_store_lds(v2, mods, mods + DM + 2 * mi2 * DM, mods + DM + (2 * mi2 + 1) * DM, H + (size_t)row2 * DM, F.lane);
        }
    }
    SEAM(PH_MOD1);
    if (IN(PH_INPROJ)) REPS(PH_INPROJ) {
        pg8::Gemm g{DM, DM, DM}; pg8::DenseOrder S{(const char*)H, (const char*)(ws + WS_WIN), DM, DM, MT / 256, AB_IN_PAD / 256, F.G, bid, 0};
        EpiInProj<S5_NAIVE != 0> E{(bf16*)(ws + WS_UEXT), (bf16*)(ws + WS_GQ), (bf16*)(ws + WS_GK), (bf16*)(ws + WS_GV), (bf16*)(ws + WS_GR), (float*)(ws + WS_LOWR)};
        pg8::gemm_phase<decltype(E), pg8::DenseOrder, true, true>(ring, g, S, E);
        moe_convert_dyn(args, F, 0, (unsigned*)ctl + CW_QC0 + 128, CONV0_LATE + CONV0_MIXA, CONV0_INPROJ);
    }
    SEAM(PH_INPROJ);
    if (IN(PH_PREP)) {
        gla_prep(args, F);
#if !S5_NAIVE
        {
            pg8::Gemm g{512, 256, 256}; pg8::S5Order S{(const char*)(ws + WS_UEXT), (const char*)(ws + WS_SE), 512, 256, F.G, bid, (size_t)S5COLS_PAD * 512 * 2, (size_t)256 * 256 * 2};
            EpiS5E E{(bf16*)(ws + WS_LST)};
            SUBREP(3) pg8::gemm_phase<EpiS5E, pg8::S5Order, true, true>(ring, g, S, E);
        }
#endif
        moe_convert_dyn(args, F, 0, (unsigned*)ctl + CW_QC0 + 160, CONV0_LATE + CONV0_MIXA + CONV0_INPROJ, CONV0_PREP);
    }
    SEAM(PH_PREP);
    if (IN(PH_MIXA)) REPS(PH_MIXA) {
#if GLA_NAIVE
        gla_naive(args, F);
#else
        SUBREP(1) gla_pass_a(args, F);
#endif
#if S5_NAIVE
        s5_naive(args, F);
#else
        SUBREP(2) s5_scan(args, F);
#endif
#if CONV0_MIXA
        moe_convert_dyn(args, F, 0, (unsigned*)ctl + CW_QC0 + 96, CONV0_LATE, CONV0_MIXA);
#endif
    }
    SEAM(PH_MIXA);
    if (IN(PH_MIXB)) {
#if S5_NAIVE
        s5_finish_naive(args, F);
#else
        {
            pg8::Gemm g{512, 512, 512}; pg8::S5Order S{(const char*)(ws + WS_UEXT), (const char*)(ws + WS_SM), 512, 512, F.G, bid, (size_t)S5COLS_PAD * 512 * 2, (size_t)256 * 512 * 2};
            EpiS5C E{(bf16*)(ws + WS_G)};
            SUBREP(4) pg8::gemm_phase<EpiS5C, pg8::S5Order, true, true>(ring, g, S, E);
        }
#endif
#if GLA_NAIVE
        gla_finish_naive(args, F);
#else
        gla_scan(args, F);
#endif
        moe_convert_dyn(args, F, 0, (unsigned*)ctl + CW_QC0 + 192, CONV0_LATE + CONV0_MIXA + CONV0_INPROJ + CONV0_PREP, CONV0_MIXB);
    }
    SEAM(PH_MIXB);
    if (IN(PH_MIXC)) REPS(PH_MIXC) {
        {
        pg8::Gemm g{1024, 1024, 1024}; pg8::DenseOrder S{(const char*)(ws + WS_G), (const char*)(ws + WS_WGLU), 1024, 1024, MT / 256, 4, F.G, bid, 1};
        EpiGlu E{(const bf16*)(ws + WS_G), (bf16*)(ws + WS_AB)};
        pg8::gemm_phase<EpiGlu, pg8::DenseOrder, true, true, false, true>(ring, g, S, E);
            }
#if !GLA_NAIVE
#if CONV0_LATE
        {
            const bool convFirst = ((bid >> 3) & 1) != 0;
#pragma nounroll
            for (int pass = 0; pass < 4; ++pass) {
                if (pass == 1) { gla_pass_c(args, F); continue; }
                if (pass == 0 && !convFirst) continue;
                moe_convert_dyn(args, F, 0, (unsigned*)ctl + CW_QC0 + (pass == 3 ? 32 : 0), pass == 3 ? CONV0_Q1 : 0, pass == 3 ? CONV0_Q2 : CONV0_Q1);
            }
        }
#else
        SUBREP(5) gla_pass_c(args, F);
#endif
#endif
    }
    SEAM(PH_MIXC);
    if (IN(PH_OUT)) REPS(PH_OUT) {
        pg8::Gemm g{DM, DM, DM}; pg8::DenseOrder S{(const char*)(ws + WS_AB), (const char*)(ws + WS_WOUT), DM, DM, MT / 256, 8, F.G, bid, 1};
        EpiRes<true> E{args.in[I_X], args.in[I_CTX], XA, MOD + 2 * DM};
        pg8::gemm_phase<EpiRes<true>, pg8::DenseOrder, true, true, false, true>(ring, g, S, E);
    }
    SEAM(PH_OUT);
    if (IN(PH_MOD2_L0)) REPS(PH_MOD2_L0) {
        LAS float* mods = (LAS float*)F.lds;
        __syncthreads(); stage_mod_lds(mods, args.in[I_N2G], MOD, 3 * DM, 4 * DM, F.tid); __syncthreads();
        for (int row = rb0 + F.wave; row < rb1; row += 16) {
            const int row2 = row + 8; const bool has2 = row2 < rb1; const int rr2 = has2 ? row2 : row;
            int isctx, b, t, isctx2, b2, t2; row_decode(row, isctx, b, t); row_decode(rr2, isctx2, b2, t2);
            const float* mr = MOD + (size_t)(isctx ? 4 : b) * MODW; const float* mr2 = MOD + (size_t)(isctx2 ? 4 : b2) * MODW;
            f32x4 v[8], v2[8]; load_row_bf16(XA + (size_t)row * DM, v, F.lane); load_row_bf16(XA + (size_t)rr2 * DM, v2, F.lane);
            const int mi = isctx ? 4 : b, mi2 = isctx2 ? 4 : b2;
            modulate_store_lds(v, mods, mods + DM + 2 * mi * DM, mods + DM + (2 * mi + 1) * DM, H + (size_t)row * DM, F.lane);
            if (has2) modulate_store_lds(v2, mods, mods + DM + 2 * mi2 * DM, mods + DM + (2 * mi2 + 1) * DM, H + (size_t)row2 * DM, F.lane);
        }
    }
    SEAM(PH_MOD2_L0);
#define MOE_PHASES(L, NROWS, CNTW, P_ROUTER, P_ROUTE, P_GU, P_DOWN) \
    if (IN(P_ROUTER)) REPS(P_ROUTER) { \
        pg8::Gemm g{DM, DM, 512}; pg8::RouterOrder S{(const char*)H, (const char*)(ws + WS_WR + (size_t)(L) * 256 * DM * 2), (NROWS) / 256, F.G, bid}; \
        EpiRouter E{(float*)(ws + WS_LOG)}; \
        pg8::gemm_phase<EpiRouter, pg8::RouterOrder, true, true>(ring, g, S, E); \
    } \
    SEAM(P_ROUTER); \
    if (IN(P_ROUTE)) { moe_route(args, F, (NROWS), (unsigned*)ctl + (CNTW)); } \
    SEAM(P_ROUTE); \
    if (IN(P_GU)) REPS(P_GU) { \
        const int ntile = moe_tables(F, (const unsigned*)ctl + (CNTW)); \
        pg8::Gemm g{DM, DM, DM}; pg8::GroupOrder S{(const char*)H, (const char*)(ws + WS_WGU), DM, DM, ntile, 8, F.G, bid, (size_t)2048 * 2048 * 2, (const LAS int*)(F.lds + LDS_TAB), (const int*)(ws + WS_LIST)}; \
        EpiGU E{(bf16*)(ws + WS_HH)}; \
        pg8::gemm_phase<EpiGU, pg8::GroupOrder, true, true, true>(ring, g, S, E); \
    } \
    SEAM(P_GU); \
    if (IN(P_DOWN)) REPS(P_DOWN) { \
        const int ntile = moe_tables(F, (const unsigned*)ctl + (CNTW)); \
        pg8::Gemm g{MOEF, MOEF, MOEF}; pg8::GroupOrder S{(const char*)(ws + WS_HH), (const char*)(ws + WS_WD), MOEF, MOEF, ntile, 8, F.G, bid, (size_t)2048 * 1024 * 2, (const LAS int*)(F.lds + LDS_TAB), nullptr}; \
        EpiDown E{(bf16*)(ws + WS_Y), (const float*)(ws + WS_WLIST), (const LAS int*)(F.lds + LDS_TAB)}; \
        pg8::gemm_phase<EpiDown, pg8::GroupOrder, true, true>(ring, g, S, E); \
    } \
    SEAM(P_DOWN);
    MOE_PHASES(0, MT, CW_CNT0, PH_ROUTER_L0, PH_ROUTE_L0, PH_GU_L0, PH_DOWN_L0)
    if (IN(PH_COMB_L0)) {
        (void)moe_tables(F, (const unsigned*)ctl + CW_CNT0);
        LAS float* mods = (LAS float*)F.lds;
        stage_mod_lds(mods, args.in[I_N1G] + DM, MOD + (size_t)5 * MODW, 0, DM, F.tid);
        LAS float* g2s = mods + 11 * DM;
        for (int i = F.tid; i < 5 * DM / 4; i += 512) { const int r = i / (DM / 4), c = (i % (DM / 4)) * 4; *(LAS f32x4*)(g2s + r * DM + c) = *(const f32x4*)(MOD + (size_t)r * MODW + 5 * DM + c); }
        __syncthreads();
        for (int row = rb0 + F.wave; row < rb1; row += 16) {
            const int row2 = row + 8; const bool has2 = row2 < rb1; const int rr2 = has2 ? row2 : row;
            int isctx, b, t, isctx2, b2, t2; row_decode(row, isctx, b, t); row_decode(rr2, isctx2, b2, t2);
            f32x4 v[8], v2[8]; moe_combine_row(args, (const LAS int*)(F.lds + LDS_TAB) + 384, g2s, row, 0, v, F.lane); moe_combine_row(args, (const LAS int*)(F.lds + LDS_TAB) + 384, g2s, rr2, 0, v2, F.lane);
            store_row_bf16(XA + (size_t)row * DM, v, F.lane);
            const float* mr = MOD + (size_t)(5 + (isctx ? 4 : b)) * MODW; const float* mr2 = MOD + (size_t)(5 + (isctx2 ? 4 : b2)) * MODW;
            const int mi = isctx ? 4 : b, mi2 = isctx2 ? 4 : b2;
            modulate_store_lds(v, mods, mods + DM + 2 * mi * DM, mods + DM + (2 * mi + 1) * DM, H + (size_t)row * DM, F.lane);
            if (has2) {
                store_row_bf16(XA + (size_t)row2 * DM, v2, F.lane);
                modulate_store_lds(v2, mods, mods + DM + 2 * mi2 * DM, mods + DM + (2 * mi2 + 1) * DM, H + (size_t)row2 * DM, F.lane);
            }
        }
    }
    SEAM(PH_COMB_L0);
    if (IN(PH_QKV)) REPS(PH_QKV) {
        pg8::Gemm g{DM, DM, DM}; pg8::DenseOrder S{(const char*)H, (const char*)(ws + WS_WQKV), DM, DM, MT / 256, 24, F.G, bid, 1};
        EpiQKV E{(bf16*)(ws + WS_Q), (size_t)(WS_K - WS_Q) / 2};
        pg8::gemm_phase<EpiQKV, pg8::DenseOrder, true, true, false, true>(ring, g, S, E);
    }
    SEAM(PH_QKV);
#if !(K_NORM_IN_NA && NA_CONV_OVERLAP)
    if (IN(PH_QKNORM)) { qk_norm(args, F);
#if !NA_CONV_OVERLAP
        moe_convert_items(args, F, 1, F.gw, F.NGW);
#endif
    }
    SEAM(PH_QKNORM);
#endif
    if (IN(PH_NA)) REPS(PH_NA) {
#if NA_NAIVE
        na_naive(args, F);
#elif NA_CONV_OVERLAP
        {
            unsigned* qcv = (unsigned*)ctl + CW_QCV; const bool xq = (F.G % 8 == 0); const int xcd = xq ? (bid & 7) : 0;
            unsigned* qna = (unsigned*)ctl + CW_QNA + 32 * xcd; const int qb = xq ? xcd * (NB * NAH * 2) : 0, qe = xq ? qb + NB * NAH * 2 : NB * NAH * 16;
            const bool convFirst = ((bid >> 3) & 3) < NA_CONV_FIRST_Q;
#pragma nounroll
            for (int pass = 0; pass < 2; ++pass) {
                if ((pass == 0) == convFirst) moe_convert_dyn(args, F, 1, qcv);
                else na_fast<true>(args, F, qna, qb, qe);
            }
        }
#else
        na_fast<false>(args, F, nullptr, 0, 0);
#endif
    }
    SEAM(PH_NA);
    if (IN(PH_NAO)) {
        pg8::Gemm g{DM, DM, DM}; pg8::DenseOrder S{(const char*)(ws + WS_O), (const char*)(ws + WS_WNAO), DM, DM, NX / 256, 8, F.G, bid, 0};
        EpiRes<false> E{nullptr, nullptr, XA, MOD + (size_t)5 * MODW + 2 * DM};
        pg8::gemm_phase<EpiRes<false>, pg8::DenseOrder, true, true>(ring, g, S, E);
    }
    SEAM(PH_NAO);
    if (IN(PH_MOD2_L1)) REPS(PH_MOD2_L1) {
        LAS float* mods = (LAS float*)F.lds;
        __syncthreads(); stage_mod_lds(mods, args.in[I_N2G] + DM, MOD + (size_t)5 * MODW, 3 * DM, 4 * DM, F.tid); __syncthreads();
        for (int row = F.gw; row < NX; row += 2 * F.NGW) {
            const int row2 = row + F.NGW; const bool has2 = row2 < NX; const int rr2 = has2 ? row2 : row;
            const float* mr = MOD + (size_t)(5 + (row >> 12)) * MODW; const float* mr2 = MOD + (size_t)(5 + (rr2 >> 12)) * MODW;
            f32x4 v[8], v2[8]; load_row_bf16(XA + (size_t)row * DM, v, F.lane); load_row_bf16(XA + (size_t)rr2 * DM, v2, F.lane);
            const int mi = row >> 12, mi2 = rr2 >> 12;
            modulate_store_lds(v, mods, mods + DM + 2 * mi * DM, mods + DM + (2 * mi + 1) * DM, H + (size_t)row * DM, F.lane);
            if (has2) modulate_store_lds(v2, mods, mods + DM + 2 * mi2 * DM, mods + DM + (2 * mi2 + 1) * DM, H + (size_t)row2 * DM, F.lane);
        }
    }
    SEAM(PH_MOD2_L1);
    MOE_PHASES(1, NX, CW_CNT1, PH_ROUTER_L1, PH_ROUTE_L1, PH_GU_L1, PH_DOWN_L1)
    if (IN(PH_COMB_L1)) REPS(PH_COMB_L1) {
        (void)moe_tables(F, (const unsigned*)ctl + CW_CNT1);
        LAS float* g2s = (LAS float*)F.lds;
        for (int i = F.tid; i < 5 * DM / 4; i += 512) { const int r = i / (DM / 4), c = (i % (DM / 4)) * 4; *(LAS f32x4*)(g2s + r * DM + c) = *(const f32x4*)(MOD + (size_t)(5 + r) * MODW + 5 * DM + c); }
        __syncthreads();
        for (int row = F.gw; row < NX; row += 2 * F.NGW) {
            const int row2 = row + F.NGW; const bool has2 = row2 < NX; const int rr2 = has2 ? row2 : row;
            f32x4 v[8], v2[8]; moe_combine_row(args, (const LAS int*)(F.lds + LDS_TAB) + 384, g2s, row, 1, v, F.lane); moe_combine_row(args, (const LAS int*)(F.lds + LDS_TAB) + 384, g2s, rr2, 1, v2, F.lane);
#pragma unroll
            for (int j = 0; j < 8; ++j) *(f32x4*)(args.out + (size_t)row * DM + 4 * F.lane + 256 * j) = v[j];
            if (has2) {
#pragma unroll
                for (int j = 0; j < 8; ++j) *(f32x4*)(args.out + (size_t)row2 * DM + 4 * F.lane + 256 * j) = v2[j];
            }
        }
    }
#undef IN
#undef SEAM
}

extern "C" void kernel_launch(void* const* d_in, const int* in_sizes, int n_in, void* d_out, int out_size, void* d_ws, size_t ws_size, hipStream_t stream) {
    static int grid = 0;
    if (grid == 0) {
        if (n_in != 32 || out_size != NX * DM || ws_size < WS_YD  ) { fprintf(stderr, "kernel_launch: unexpected shapes (n_in %d, out %d, ws %zu)\n", n_in, out_size, ws_size); grid = -1; return; }
        int dev = 0, cus = 0, per_cu = 0;
        if (hipGetDevice(&dev) != hipSuccess || hipDeviceGetAttribute(&cus, hipDeviceAttributeMultiprocessorCount, dev) != hipSuccess) { grid = -1; return; }
        if (hipFuncSetAttribute((const void*)fwd_kernel, hipFuncAttributeMaxDynamicSharedMemorySize, LDS_BYTES) != hipSuccess) { fprintf(stderr, "kernel_launch: hipFuncSetAttribute failed\n"); grid = -1; return; }
        if (hipOccupancyMaxActiveBlocksPerMultiprocessor(&per_cu, (const void*)fwd_kernel, 512, LDS_BYTES) != hipSuccess || per_cu < 1) fprintf(stderr, "kernel_launch: occupancy query says %d\n", per_cu);
        (void)hipGetLastError();
        grid = cus;
    }
    if (grid < 0) return;
    (void)hipMemsetAsync((char*)d_ws + WS_CTL, 0, CTL_ZERO_BYTES, stream);
    Args a{};
    for (int i = 0; i < 32; ++i) a.in[i] = (const float*)d_in[i];
    a.out = (float*)d_out; a.ws = (unsigned char*)d_ws; a.pad = 0;
#if MK_PER_PHASE
    for (int p = 0; p < NPH; ++p) { a.ph_lo = p; a.ph_hi = p + 1; a.use_bar = 0; hipLaunchKernelGGL(fwd_kernel, dim3(grid), dim3(512), LDS_BYTES, stream, a); }
#else
    a.ph_lo = 0; a.ph_hi = NPH; a.use_bar = 1;
    hipLaunchKernelGGL(fwd_kernel, dim3(grid), dim3(512), LDS_BYTES, stream, a);
#endif
}
```

```cpp
#include <hip/hip_runtime.h>
#include <cstdio>
#include <cstdint>

#define LAS __attribute__((address_space(3)))
#define GAS __attribute__((address_space(1)))
typedef unsigned short bf16;
typedef short bf16x8 __attribute__((ext_vector_type(8)));
typedef float f32x4 __attribute__((ext_vector_type(4)));
typedef float f32x2 __attribute__((ext_vector_type(2)));
typedef float f32x16 __attribute__((ext_vector_type(16)));
typedef unsigned u32x4 __attribute__((ext_vector_type(4)));
typedef unsigned u32x2 __attribute__((ext_vector_type(2)));
typedef GAS unsigned gu32;

constexpr int DM = 2048, NB = 4, SEQ = 4096, CTX = 256;
constexpr int NX = NB * SEQ, NC = NB * CTX, MT = NX + NC;
constexpr int NMOD = 6, MODW = NMOD * DM;
constexpr int AW = 1024, S5G = 64, S5I = 16, S5P = 64;
constexpr int GH = 4, GDV = 256, GDK = 128, GQK = 512, GRANK = 16;
constexpr int AB_IN = 4128, AB_IN_PAD = 4352;
constexpr int NAH = 16, NAD = 128;
constexpr int NE = 32, MOEF = 1024;
constexpr float EPS = 1e-6f;
constexpr int PMAX = 43008;
constexpr int S5T = 16, S5COLS = 1088, S5COLS_PAD = 1280;

constexpr size_t MiB = 1u << 20;
constexpr size_t WS_CTL = 0, CTL_ZERO_BYTES = 1 * MiB;
constexpr size_t WS_MOD = 1 * MiB;
constexpr size_t WS_WIN = 2 * MiB;
constexpr size_t WS_WGLU = WS_WIN + 17 * MiB;
constexpr size_t WS_WOUT = WS_WGLU + 2 * MiB;
constexpr size_t WS_WQKV = WS_WOUT + 8 * MiB;
constexpr size_t WS_WNAO = WS_WQKV + 24 * MiB;
constexpr size_t WS_WR = WS_WNAO + 8 * MiB;
constexpr size_t WS_WGU = WS_WR + 2 * MiB;
constexpr size_t WS_WD = WS_WGU + 256 * MiB;
constexpr size_t WS_SM = WS_WD + 128 * MiB;
constexpr size_t WS_SE = WS_SM + 16 * MiB;
constexpr size_t WS_XA = WS_SE + 8 * MiB;
constexpr size_t WS_H = WS_XA + 136 * MiB;
constexpr size_t WS_ACT = WS_H + 68 * MiB;
constexpr size_t WS_UEXT = WS_ACT;
constexpr size_t WS_LST = WS_UEXT + 80 * MiB;
constexpr size_t WS_GQ = WS_LST + 80 * MiB;
constexpr size_t WS_GK = WS_GQ + 17 * MiB;
constexpr size_t WS_GV = WS_GK + 17 * MiB;
constexpr size_t WS_GR = WS_GV + 34 * MiB;
constexpr size_t WS_LOWR = WS_GR + 34 * MiB;
constexpr size_t WS_LA = WS_LOWR + 3 * MiB;
constexpr size_t WS_G = WS_LA + 68 * MiB;
constexpr size_t WS_AB = WS_G + 34 * MiB;
constexpr size_t WS_UC = WS_AB + 68 * MiB;
constexpr size_t WS_DEC = WS_UC + 272 * MiB;
constexpr size_t WS_YD = WS_DEC + 2 * MiB;
constexpr size_t WS_MIX_END = WS_YD + 136 * MiB;
constexpr size_t WS_LOG = WS_ACT;
constexpr size_t WS_ROUTE = WS_LOG + 18 * MiB;
constexpr size_t WS_ROWW = WS_ROUTE + 1 * MiB;
constexpr size_t WS_LIST = WS_ROWW + 1 * MiB;
constexpr size_t WS_WLIST = WS_LIST + 3 * MiB;
constexpr size_t WS_HH = WS_WLIST + 3 * MiB;
constexpr size_t WS_Y = WS_HH + 84 * MiB;
constexpr size_t WS_MOE_END = WS_Y + 168 * MiB;
constexpr size_t WS_Q = WS_ACT;
constexpr size_t WS_K = WS_Q + 68 * MiB;
constexpr size_t WS_V = WS_K + 68 * MiB;
constexpr size_t WS_O = WS_V + 68 * MiB;
constexpr size_t WS_END = 2048 * MiB;
static_assert(WS_MIX_END <= WS_END && WS_MOE_END <= WS_END && WS_O + 64 * MiB <= WS_END, "d_ws map");

constexpr int CW_TMO = 0;
constexpr int CW_CNT0 = 256, CW_CNT1 = 512;
constexpr int CW_QCV = 1024, CW_QNA = 1280;
constexpr int CW_QC0 = 1536;
constexpr int CW_BAR = 4096;

constexpr int RING_BYTES = 131072;
constexpr int LDS_TAB = RING_BYTES;
constexpr int LDS_MISC = RING_BYTES + 4096;
constexpr int LDS_BYTES = 147456;

#define LDS_WAIT() asm volatile("s_waitcnt lgkmcnt(0)" ::: "memory")
#define VM_WAIT() asm volatile("s_waitcnt vmcnt(0)" ::: "memory")
__device__ __forceinline__ unsigned f2bf(float f) { unsigned u = __builtin_bit_cast(unsigned, f); return (u + 0x7fffu + ((u >> 16) & 1u)) >> 16; }
__device__ __forceinline__ unsigned pk2(float lo, float hi) { return f2bf(lo) | (f2bf(hi) << 16); }
__device__ __forceinline__ float bf2f(unsigned b) { return __builtin_bit_cast(float, b << 16); }
__device__ __forceinline__ float bflo(unsigned w) { return __builtin_bit_cast(float, w << 16); }
__device__ __forceinline__ float bfhi(unsigned w) { return __builtin_bit_cast(float, w & 0xffff0000u); }
__device__ __forceinline__ float wave_sum(float v) {
#pragma unroll
    for (int o = 1; o < 64; o <<= 1) v += __shfl_xor(v, o);
    return v;
}
__device__ __forceinline__ float wave_max(float v) {
#pragma unroll
    for (int o = 1; o < 64; o <<= 1) v = fmaxf(v, __shfl_xor(v, o));
    return v;
}
__device__ __forceinline__ float silu_f(float x) { return x * __builtin_amdgcn_rcpf(1.0f + __expf(-x)); }
__device__ __forceinline__ float sigmoid_f(float x) { return __builtin_amdgcn_rcpf(1.0f + __expf(-x)); }
__device__ __forceinline__ float gelu_tanh_f(float x) { const float z = 0.7978845608028654f * (x + 0.044715f * x * x * x); const float e = __expf(2.0f * z); return 0.5f * x * (2.0f - 2.0f * __builtin_amdgcn_rcpf(1.0f + e)); }
__device__ __forceinline__ void row_decode(int row, int& isctx, int& b, int& t) {
    if (row < NX) { isctx = 0; b = row >> 12; t = row & 4095; } else { const int rr = row - NX; isctx = 1; b = rr >> 8; t = rr & 255; }
}

#ifndef PROBE_EPI2
#define PROBE_EPI2 0
#endif
namespace pg8 {
#define PG8_LAS __attribute__((address_space(3)))
constexpr int BM = 256, BK = 64, HALF = 128, HTB = HALF * BK * 2, STAGE_BYTES = 8 * HTB, NXCD = 8, WGM = 8;
__host__ __device__ __forceinline__ int lds_byte(int r, int c) { const int st = (r >> 4) * 2 + (c >> 5), rr = r & 15, cc = c & 31, ob = rr * 64 + cc * 2; return st * 1024 + (ob ^ (((ob >> 9) & 1) << 5)); }
__host__ __device__ __forceinline__ void stage_rc(int b, int& R, int& C) { const int st = b / 1024, sb = b % 1024, swz = sb ^ (((sb >> 9) & 1) << 5); R = (st >> 1) * 16 + swz / 64; C = (st & 1) * 32 + (swz % 64) / 2; }
__host__ __device__ __forceinline__ int perm32(int rho) { const int n = rho >> 4, i = rho & 15; return 8 * (i >> 2) + 4 * n + (i & 3); }

struct Unit { int pm, pn; const char* A; const char* B; const int* rows; int nvalid; int skip; };
struct Gemm { int lda, ldb, K; };

__device__ __forceinline__ bool tile_order(long L, int nM, int nN, int& pm, int& pn) {
    const int nwg = nM * nN; if (L >= nwg) return false;
    int wgid = (int)L; { const int q = nwg / NXCD, r = nwg % NXCD, xcd = wgid % NXCD, off = wgid / NXCD; wgid = (xcd < r ? xcd * (q + 1) : r * (q + 1) + (xcd - r) * q) + off; }
    const int nig = WGM * nN, gid = wgid / nig, fm = gid * WGM, gsz = (nM - fm) < WGM ? (nM - fm) : WGM;
    pm = fm + ((wgid % nig) % gsz); pn = (wgid % nig) / gsz; return true;
}
struct DenseOrder {
    const char* A; const char* B; int lda, ldb, nM, nN, G, c; int split;
    __device__ __forceinline__ bool next(int i, Unit& u) const {
        long L = (long)i * G + c; u.skip = 0;
        if (split) {
            const int nwg = nM * nN, R = (nwg + G - 1) / G, T = nwg - (R - 1) * G;
            if (i == R - 1 && T < G) {
                const int S = (4 * T <= G) ? 4 : ((2 * T <= G) ? 2 : 1);
                if (c >= S * T) return false;
                const int part = c % S; L = (long)(R - 1) * G + c / S;
                if (S == 2) u.skip = part ? 1 : 2;
                if (S == 4) u.skip = ((part & 1) ? 1 : 2) | ((part >> 1) ? 4 : 8);
            }
        }
        if (!tile_order(L, nM, nN, u.pm, u.pn)) return false;
        u.A = A + (size_t)u.pm * BM * lda * 2; u.B = B + (size_t)u.pn * BM * ldb * 2; return true;
    }
};
struct GroupOrder {
    const char* A; const char* B; int lda, ldb, nM, nN, G, c; size_t estride; const PG8_LAS int* tab;
    const int* list;
    __device__ __forceinline__ bool next(int i, Unit& u) const {
        if (!tile_order((long)i * G + c, nM, nN, u.pm, u.pn)) return false;
        const int e = __builtin_amdgcn_readfirstlane(tab[u.pm]);
        u.B = B + (size_t)e * estride + (size_t)u.pn * BM * ldb * 2;
        if (list) { const int j = __builtin_amdgcn_readfirstlane(tab[176 + u.pm]), cnt = __builtin_amdgcn_readfirstlane(tab[352 + e]); u.A = A; u.rows = list + (size_t)e * MT + 256 * j; u.nvalid = cnt - 256 * j; }
        else u.A = A + (size_t)u.pm * BM * lda * 2;
        return true;
    }
};
struct RouterOrder {
    const char* A; const char* B; int nM, G, c;
    __device__ __forceinline__ bool next(int i, Unit& u) const {
        const long L = (long)i * G + c; if (L >= (long)nM * 4) return false;
        u.pm = (int)(L >> 2); u.pn = (int)(L & 3);
        u.A = A + (size_t)u.pm * BM * DM * 2 + (size_t)u.pn * 512 * 2; u.B = B + (size_t)u.pn * 512 * 2; return true;
    }
};
struct S5Order {
    const char* A; const char* B; int lda, ldb, G, c; size_t astride, bstride;
    __device__ __forceinline__ bool next(int i, Unit& u) const {
        const long L = (long)i * G + c; if (L >= 64 * 5) return false;
        u.pn = (int)(L / 5); u.pm = (int)(L % 5);
        u.A = A + (size_t)u.pn * astride + (size_t)u.pm * BM * lda * 2; u.B = B + (size_t)u.pn * bstride; return true;
    }
};

__device__ __forceinline__ unsigned cvt_pk_bf16(float lo, float hi) { unsigned r; asm volatile("v_cvt_pk_bf16_f32 %0, %1, %2" : "=v"(r) : "v"(lo), "v"(hi)); return r; }

template <class Epi, class Sched, bool ALIGN_EPI = false, bool SP2 = false, bool GATHER = false, bool SPLIT = false>
__device__ __forceinline__ void gemm_phase(PG8_LAS unsigned char* lds, const Gemm g, const Sched& S, const Epi& E) {
    const int tid = threadIdx.x, wid = __builtin_amdgcn_readfirstlane(tid >> 6), lane = tid & 63, wr = wid >> 2, wc = wid & 3, fr = lane & 15, fq = lane >> 4;
    int Kop = g.K; asm volatile("" : "+s"(Kop));
    const int K = Kop, nt = K / BK;
    unsigned voffA[2], voffB[2]; int RA[2], CA[2];
#pragma unroll
    for (int i = 0; i < 2; ++i) { int R, C; stage_rc(tid * 16 + i * 8192, R, C); const int Rb = Epi::PERM ? ((R & ~31) + perm32(R & 31)) : R; RA[i] = R; CA[i] = C;
        voffA[i] = (unsigned)(R * g.lda + C) * 2u; voffB[i] = (unsigned)(Rb * g.ldb + C) * 2u; }
    unsigned goffC[2][2], goffN[2][2];
#define PG8_GOFF(dst, u) do { _Pragma("unroll") for (int _h = 0; _h < 2; ++_h) _Pragma("unroll") for (int _i = 0; _i < 2; ++_i) { const int _pos = _h * HALF + RA[_i]; \
        const int _idx = _pos < (u).nvalid ? (u).rows[_pos] : 0; dst[_h][_i] = ((unsigned)_idx * (unsigned)g.lda + (unsigned)CA[_i]) * 2u; } } while (0)
    const size_t kstep = (size_t)(BK * 2);
    const size_t hstepA = (size_t)HALF * g.lda * 2, hstepB = (size_t)HALF * g.ldb * 2;
    const unsigned ldsw = (unsigned)wid * 1024u;
    const int aoff = lds_byte(wr * 64 + fr, fq * 8), boff = lds_byte(wc * 32 + fr, fq * 8);
#define PG8_SA(b, h) (((b) * 2 + (h)) * HTB)
#define PG8_SB(b, h) ((4 + (b) * 2 + (h)) * HTB)
#define PG8_STAGE(bufoff, gbase, voff) do { _Pragma("unroll") for (int _i = 0; _i < 2; ++_i) \
        __builtin_amdgcn_global_load_lds((const unsigned*)((const char*)(gbase) + (voff)[_i]), (PG8_LAS unsigned*)(lds + (bufoff) + ldsw + _i * 8192), 16, 0, 0); } while (0)
#define PG8_STAGE_A(bufoff, usenext, h, ptr, kb) do { if constexpr (GATHER) { _Pragma("unroll") for (int _i = 0; _i < 2; ++_i) { const unsigned _o = (usenext) ? goffN[h][_i] : goffC[h][_i]; \
        __builtin_amdgcn_global_load_lds((const unsigned*)(cA + (kb) + _o), (PG8_LAS unsigned*)(lds + (bufoff) + ldsw + _i * 8192), 16, 0, 0); } } \
        else { PG8_STAGE(bufoff, (ptr) + (h) * hstepA, voffA); } } while (0)
#define PG8_LDA(dst, b, h) do { _Pragma("unroll") for (int m = 0; m < 4; ++m) _Pragma("unroll") for (int k = 0; k < 2; ++k) dst[m][k] = *(const PG8_LAS bf16x8*)(lds + PG8_SA(b, h) + aoff + m * 2048 + k * 1024); } while (0)
#define PG8_LDB(dst, b, h) do { _Pragma("unroll") for (int n = 0; n < 2; ++n) _Pragma("unroll") for (int k = 0; k < 2; ++k) dst[n][k] = *(const PG8_LAS bf16x8*)(lds + PG8_SB(b, h) + boff + n * 2048 + k * 1024); } while (0)
#define PG8_MMA(ai, bj, At, Bt) do { __builtin_amdgcn_s_setprio(1); _Pragma("unroll") for (int m = 0; m < 4; ++m) _Pragma("unroll") for (int n = 0; n < 2; ++n) _Pragma("unroll") for (int k = 0; k < 2; ++k) \
        acc[ai][bj][m][n] = __builtin_amdgcn_mfma_f32_16x16x32_bf16(Bt[n][k], At[m][k], acc[ai][bj][m][n], 0, 0, 0); __builtin_amdgcn_s_setprio(0); } while (0)
#define PG8_MMA2(ai) do { if constexpr (SPLIT) { if (!(cur.skip & (4 << (ai)))) { if (!(cur.skip & 1)) PG8_MMA(ai, 0, At, B0); if (!(cur.skip & 2)) PG8_MMA(ai, 1, At, B1); } } \
        else { PG8_MMA(ai, 0, At, B0); PG8_MMA(ai, 1, At, B1); } } while (0)
#define PG8_WAIT_V(n) asm volatile("s_waitcnt vmcnt(" #n ")" ::: "memory")
#define PG8_WAIT_L(n) asm volatile("s_waitcnt lgkmcnt(" #n ")" ::: "memory")
#define PG8_BAR __builtin_amdgcn_s_barrier()
#define PG8_SCHED __builtin_amdgcn_sched_barrier(0)
    Unit cur, nxt; int ui = 0;
    if (!S.next(0, cur)) return;
    f32x4 acc[2][2][4][2];
#pragma unroll
    for (int a = 0; a < 2; ++a)
#pragma unroll
        for (int b = 0; b < 2; ++b)
#pragma unroll
            for (int m = 0; m < 4; ++m)
#pragma unroll
                for (int n = 0; n < 2; ++n) acc[a][b][m][n] = (f32x4){0.f, 0.f, 0.f, 0.f};
    bf16x8 At[4][2], B0[2][2], B1[2][2];
    const char* cA = cur.A; const char* cB = cur.B;
    if constexpr (GATHER) { PG8_GOFF(goffC, cur); _Pragma("unroll") for (int _h = 0; _h < 2; ++_h) _Pragma("unroll") for (int _i = 0; _i < 2; ++_i) goffN[_h][_i] = goffC[_h][_i]; }
    if constexpr (SP2) {
        PG8_STAGE(PG8_SB(0, 0), cB, voffB); PG8_STAGE(PG8_SB(0, 1), cB + hstepB, voffB); PG8_STAGE_A(PG8_SA(0, 0), false, 0, cA, 0); PG8_STAGE_A(PG8_SA(0, 1), false, 1, cA, 0);
        if (wr == 1) PG8_BAR;
        PG8_WAIT_V(2); PG8_BAR;
        PG8_STAGE(PG8_SB(1, 0), cB + kstep, voffB); PG8_STAGE_A(PG8_SA(1, 0), false, 0, cA + kstep, kstep); PG8_STAGE(PG8_SB(1, 1), cB + hstepB + kstep, voffB);
        PG8_WAIT_V(6); PG8_BAR;
    } else {
        PG8_STAGE(PG8_SB(0, 0), cB, voffB); PG8_STAGE(PG8_SA(0, 0), cA, voffA); PG8_STAGE(PG8_SB(0, 1), cB + hstepB, voffB); PG8_STAGE(PG8_SA(0, 1), cA + hstepA, voffA);
        if (wr == 1) PG8_BAR;
        PG8_WAIT_V(4); PG8_BAR;
        PG8_STAGE(PG8_SB(1, 0), cB + kstep, voffB); PG8_STAGE(PG8_SA(1, 0), cA + kstep, voffA); PG8_STAGE(PG8_SB(1, 1), cB + hstepB + kstep, voffB);
        PG8_WAIT_V(6); PG8_BAR;
    }
    for (;;) {
        const bool has_next = S.next(ui + 1, nxt);
        const char* nA = has_next ? nxt.A : cA; const char* nB = has_next ? nxt.B : cB;
        if constexpr (GATHER) { if (has_next) PG8_GOFF(goffN, nxt); else { _Pragma("unroll") for (int _h = 0; _h < 2; ++_h) _Pragma("unroll") for (int _i = 0; _i < 2; ++_i) goffN[_h][_i] = goffC[_h][_i]; } }
        for (int t = 0; t < nt; t += 2) {
            const bool last = (t == nt - 2);
            const char* a1 = cA + (size_t)(t + 1) * kstep;
            const char* a2 = last ? nA : cA + (size_t)(t + 2) * kstep; const char* b2 = last ? nB : cB + (size_t)(t + 2) * kstep;
            const char* a3 = a2 + kstep; const char* b3 = b2 + kstep;
            if constexpr (SP2) {
            const size_t kb1 = (size_t)(t + 1) * kstep, kb2 = last ? 0 : (size_t)(t + 2) * kstep, kb3 = kb2 + kstep;
            PG8_LDB(B0, 0, 0); PG8_LDB(B1, 0, 1); PG8_SCHED; PG8_LDA(At, 0, 0); PG8_STAGE_A(PG8_SA(1, 1), false, 1, a1, kb1);
            PG8_WAIT_V(8); PG8_WAIT_L(0); PG8_BAR; PG8_MMA2(0); PG8_BAR; PG8_SCHED;
            PG8_LDA(At, 0, 1); PG8_STAGE(PG8_SB(0, 0), b2, voffB); PG8_STAGE(PG8_SB(0, 1), b2 + hstepB, voffB); PG8_STAGE_A(PG8_SA(0, 0), last, 0, a2, kb2);
            PG8_WAIT_V(8); PG8_WAIT_L(0); PG8_BAR; PG8_MMA2(1); PG8_BAR; PG8_SCHED;
            PG8_LDB(B0, 1, 0); PG8_LDB(B1, 1, 1); PG8_SCHED; PG8_LDA(At, 1, 0); PG8_STAGE_A(PG8_SA(0, 1), last, 1, a2, kb2);
            PG8_WAIT_V(8); PG8_WAIT_L(0); PG8_BAR; PG8_MMA2(0); PG8_BAR; PG8_SCHED;
            PG8_LDA(At, 1, 1); PG8_STAGE(PG8_SB(1, 0), b3, voffB); PG8_STAGE(PG8_SB(1, 1), b3 + hstepB, voffB); PG8_STAGE_A(PG8_SA(1, 0), last, 0, a3, kb3);
            PG8_WAIT_V(8); PG8_WAIT_L(0); PG8_BAR; PG8_MMA2(1); PG8_BAR; PG8_SCHED;
            } else {
            PG8_LDB(B0, 0, 0); PG8_SCHED; PG8_LDA(At, 0, 0); PG8_STAGE(PG8_SA(1, 1), a1 + hstepA, voffA);
            PG8_WAIT_L(8); PG8_BAR; PG8_WAIT_L(0); PG8_MMA(0, 0, At, B0); PG8_BAR; PG8_SCHED;
            PG8_LDB(B1, 0, 1); PG8_STAGE(PG8_SB(0, 0), b2, voffB);
            PG8_BAR; PG8_WAIT_L(0); PG8_MMA(0, 1, At, B1); PG8_BAR;
            PG8_LDA(At, 0, 1); PG8_STAGE(PG8_SA(0, 0), a2, voffA);
            PG8_BAR; PG8_WAIT_L(0); PG8_MMA(1, 0, At, B0); PG8_BAR; PG8_SCHED;
            PG8_STAGE(PG8_SB(0, 1), b2 + hstepB, voffB);
            PG8_WAIT_V(6); PG8_BAR; PG8_MMA(1, 1, At, B1); PG8_BAR;
            PG8_LDB(B0, 1, 0); PG8_SCHED; PG8_LDA(At, 1, 0); PG8_STAGE(PG8_SA(0, 1), a2 + hstepA, voffA);
            PG8_WAIT_L(8); PG8_BAR; PG8_WAIT_L(0); PG8_MMA(0, 0, At, B0); PG8_BAR; PG8_SCHED;
            PG8_LDB(B1, 1, 1); PG8_STAGE(PG8_SB(1, 0), b3, voffB);
            PG8_BAR; PG8_WAIT_L(0); PG8_MMA(0, 1, At, B1); PG8_BAR;
            PG8_LDA(At, 1, 1); PG8_STAGE(PG8_SA(1, 0), a3, voffA);
            PG8_BAR; PG8_WAIT_L(0); PG8_MMA(1, 0, At, B0); PG8_BAR; PG8_SCHED;
            PG8_STAGE(PG8_SB(1, 1), b3 + hstepB, voffB);
            PG8_WAIT_V(6); PG8_BAR; PG8_MMA(1, 1, At, B1); PG8_BAR;
            }
        }
        if constexpr (ALIGN_EPI) { if (wr == 0) PG8_BAR; }
        E(acc, cur, wr, wc, fr, fq);
#if PROBE_EPI2
        if constexpr (!Epi::INPLACE) E(acc, cur, wr, wc, fr, fq);
#endif
        if (!has_next) break;
#pragma unroll
        for (int a = 0; a < 2; ++a)
#pragma unroll
            for (int b = 0; b < 2; ++b)
#pragma unroll
                for (int m = 0; m < 4; ++m)
#pragma unroll
                    for (int n = 0; n < 2; ++n) acc[a][b][m][n] = (f32x4){0.f, 0.f, 0.f, 0.f};
        cur = nxt; cA = nA; cB = nB; ++ui;
        if constexpr (GATHER) { _Pragma("unroll") for (int _h = 0; _h < 2; ++_h) _Pragma("unroll") for (int _i = 0; _i < 2; ++_i) goffC[_h][_i] = goffN[_h][_i]; }
        if constexpr (ALIGN_EPI) { if (wr == 1) PG8_BAR; }
    }
    PG8_WAIT_V(0);
    if constexpr (!ALIGN_EPI) { if (wr == 0) PG8_BAR; }
    PG8_BAR;
#undef PG8_SA
#undef PG8_SB
#undef PG8_STAGE
#undef PG8_STAGE_A
#undef PG8_GOFF
#undef PG8_LDA
#undef PG8_LDB
#undef PG8_MMA
#undef PG8_MMA2
#undef PG8_WAIT_V
#undef PG8_WAIT_L
#undef PG8_BAR
#undef PG8_SCHED
}
}

using pg8::Unit; using pg8::cvt_pk_bf16;
#define EPI_LOOP_AM for (int ai = 0; ai < 2; ++ai) _Pragma("unroll") for (int m = 0; m < 4; ++m)
__device__ __forceinline__ u32x4 pack8(const f32x4 v0, const f32x4 v1) { u32x4 w; w.x = cvt_pk_bf16(v0[0], v0[1]); w.y = cvt_pk_bf16(v0[2], v0[3]); w.z = cvt_pk_bf16(v1[0], v1[1]); w.w = cvt_pk_bf16(v1[2], v1[3]); return w; }

template <bool S5NAIVE> struct EpiInProj {
    static constexpr bool PERM = true; static constexpr bool INPLACE = false;
    bf16* u_out; bf16* gq; bf16* gk; bf16* gv; bf16* gr; float* lowr;
    __device__ __forceinline__ void operator()(const f32x4 (&acc)[2][2][4][2], const Unit& u, int wr, int wc, int fr, int fq) const {
#pragma unroll
        EPI_LOOP_AM {
            const int row = u.pm * 256 + ai * 128 + wr * 64 + m * 16 + fr;
            int isctx, b, t; row_decode(row, isctx, b, t);
#pragma unroll
            for (int bj = 0; bj < 2; ++bj) {
                const int c = u.pn * 256 + bj * 128 + wc * 32 + 8 * fq;
                if (u.pn < 16) {
                    const u32x4 w = pack8(acc[ai][bj][m][0], acc[ai][bj][m][1]);
                    bf16* dst;
                    if (u.pn < 4) {
                        if (S5NAIVE) dst = u_out + (size_t)row * 1024 + c;
                        else { const int g = c >> 4, i0 = c & 15, col = b * 272 + (isctx ? 0 : 16) + (t >> 4), tt = t & 15; dst = u_out + ((size_t)(g * S5COLS_PAD + col) * 512 + tt * 16 + i0); }
                    } else if (u.pn < 6) dst = gq + (size_t)row * 512 + (c - 1024);
                    else if (u.pn < 8) dst = gk + (size_t)row * 512 + (c - 1536);
                    else if (u.pn < 12) dst = gv + (size_t)row * 1024 + (c - 2048);
                    else dst = gr + (size_t)row * 1024 + (c - 3072);
                    *(u32x4*)dst = w;
                } else if (bj == 0 && wc == 0) {
                    float* d = lowr + (size_t)row * 32 + 8 * fq;
                    *(f32x4*)d = acc[ai][bj][m][0]; *(f32x4*)(d + 4) = acc[ai][bj][m][1];
                }
            }
        }
    }
};
struct EpiGlu {
    static constexpr bool PERM = true; static constexpr bool INPLACE = false;
    const bf16* G; bf16* AB;
    __device__ __forceinline__ void operator()(const f32x4 (&acc)[2][2][4][2], const Unit& u, int wr, int wc, int fr, int fq) const {
#pragma unroll
        EPI_LOOP_AM {
            const int row = u.pm * 256 + ai * 128 + wr * 64 + m * 16 + fr;
            if (u.skip & (4 << ai)) continue;
#pragma unroll
            for (int bj = 0; bj < 2; ++bj) {
                if (u.skip & (1 << bj)) continue;
                const int c = u.pn * 256 + bj * 128 + wc * 32 + 8 * fq;
                const u32x4 gw = *(const u32x4*)(G + (size_t)row * 1024 + c);
                f32x4 v0 = acc[ai][bj][m][0], v1 = acc[ai][bj][m][1];
                v0[0] = bflo(gw.x) * sigmoid_f(v0[0]); v0[1] = bfhi(gw.x) * sigmoid_f(v0[1]); v0[2] = bflo(gw.y) * sigmoid_f(v0[2]); v0[3] = bfhi(gw.y) * sigmoid_f(v0[3]);
                v1[0] = bflo(gw.z) * sigmoid_f(v1[0]); v1[1] = bfhi(gw.z) * sigmoid_f(v1[1]); v1[2] = bflo(gw.w) * sigmoid_f(v1[2]); v1[3] = bfhi(gw.w) * sigmoid_f(v1[3]);
                *(u32x4*)(AB + (size_t)row * 2048 + c) = pack8(v0, v1);
            }
        }
    }
};
template <bool FROM_INPUT> struct EpiRes {
    static constexpr bool PERM = true; static constexpr bool INPLACE = !FROM_INPUT;
    const float* x; const float* ctx; bf16* XA; const float* gate;
    __device__ __forceinline__ void operator()(const f32x4 (&acc)[2][2][4][2], const Unit& u, int wr, int wc, int fr, int fq) const {
#pragma unroll
        EPI_LOOP_AM {
            const int row = u.pm * 256 + ai * 128 + wr * 64 + m * 16 + fr;
            int isctx, b, t; row_decode(row, isctx, b, t);
            const float* gp = gate + (size_t)(isctx ? 4 : b) * MODW;
            if (u.skip & (4 << ai)) continue;
#pragma unroll
            for (int bj = 0; bj < 2; ++bj) {
                if (u.skip & (1 << bj)) continue;
                const int c = u.pn * 256 + bj * 128 + wc * 32 + 8 * fq;
                f32x4 x0, x1;
                if (FROM_INPUT) { const float* xin = isctx ? ctx + (size_t)(row - NX) * DM : x + (size_t)row * DM; x0 = *(const f32x4*)(xin + c); x1 = *(const f32x4*)(xin + c + 4); }
                else { const u32x4 xw = *(const u32x4*)(XA + (size_t)row * DM + c); x0 = (f32x4){bflo(xw.x), bfhi(xw.x), bflo(xw.y), bfhi(xw.y)}; x1 = (f32x4){bflo(xw.z), bfhi(xw.z), bflo(xw.w), bfhi(xw.w)}; }
                const f32x4 g0 = *(const f32x4*)(gp + c), g1 = *(const f32x4*)(gp + c + 4);
                *(u32x4*)(XA + (size_t)row * DM + c) = pack8(x0 + g0 * acc[ai][bj][m][0], x1 + g1 * acc[ai][bj][m][1]);
            }
        }
    }
};
struct EpiRouter {
    static constexpr bool PERM = false; static constexpr bool INPLACE = false;
    float* LOG;
    __device__ __forceinline__ void operator()(const f32x4 (&acc)[2][2][4][2], const Unit& u, int wr, int wc, int fr, int fq) const {
        if (wc >= 2) return;
#pragma unroll
        EPI_LOOP_AM {
            const int row = u.pm * 256 + ai * 128 + wr * 64 + m * 16 + fr;
#pragma unroll
            for (int n = 0; n < 2; ++n) *(f32x4*)(LOG + ((size_t)u.pn * MT + row) * 64 + wc * 32 + 16 * n + 4 * fq) = acc[ai][0][m][n];
        }
    }
};
struct EpiGU {
    static constexpr bool PERM = true; static constexpr bool INPLACE = false;
    bf16* HH;
    __device__ __forceinline__ void operator()(const f32x4 (&acc)[2][2][4][2], const Unit& u, int wr, int wc, int fr, int fq) const {
#pragma unroll
        EPI_LOOP_AM {
            const int row = u.pm * 256 + ai * 128 + wr * 64 + m * 16 + fr;
            f32x4 v0, v1;
#pragma unroll
            for (int j = 0; j < 4; ++j) { v0[j] = silu_f(acc[ai][0][m][0][j]) * acc[ai][1][m][0][j]; v1[j] = silu_f(acc[ai][0][m][1][j]) * acc[ai][1][m][1][j]; }
            *(u32x4*)(HH + (size_t)row * MOEF + u.pn * 128 + wc * 32 + 8 * fq) = pack8(v0, v1);
        }
    }
};
struct EpiDown {
    static constexpr bool PERM = true; static constexpr bool INPLACE = false;
    bf16* Y; const float* wlist; const LAS int* tab;
    __device__ __forceinline__ void operator()(const f32x4 (&acc)[2][2][4][2], const Unit& u, int wr, int wc, int fr, int fq) const {
        const int e = tab[u.pm], j = tab[176 + u.pm], cnt = tab[352 + e];
#pragma unroll
        EPI_LOOP_AM {
            const int rr = ai * 128 + wr * 64 + m * 16 + fr, row = u.pm * 256 + rr, pos = 256 * j + rr;
            const float w = pos < cnt ? wlist[(size_t)e * MT + pos] : 0.f;
#pragma unroll
            for (int bj = 0; bj < 2; ++bj) {
                const int c = u.pn * 256 + bj * 128 + wc * 32 + 8 * fq;
                *(u32x4*)(Y + (size_t)row * DM + c) = pack8(acc[ai][bj][m][0] * w, acc[ai][bj][m][1] * w);
            }
        }
    }
};
struct EpiQKV {
    static constexpr bool PERM = true; static constexpr bool INPLACE = false;
    bf16* Q; size_t stride;
    __device__ __forceinline__ void operator()(const f32x4 (&acc)[2][2][4][2], const Unit& u, int wr, int wc, int fr, int fq) const {
        bf16* base = Q + (size_t)(u.pn >> 3) * stride; const int ct = (u.pn & 7) * 256;
#pragma unroll
        EPI_LOOP_AM {
            const int row = u.pm * 256 + ai * 128 + wr * 64 + m * 16 + fr;
#pragma unroll
            for (int bj = 0; bj < 2; ++bj) { if ((u.skip & (1 << bj)) || (u.skip & (4 << ai))) continue; *(u32x4*)(base + (size_t)row * DM + ct + bj * 128 + wc * 32 + 8 * fq) = pack8(acc[ai][bj][m][0], acc[ai][bj][m][1]); }
        }
    }
};
struct EpiS5E {
    static constexpr bool PERM = true; static constexpr bool INPLACE = false;
    bf16* LST;
    __device__ __forceinline__ void operator()(const f32x4 (&acc)[2][2][4][2], const Unit& u, int wr, int wc, int fr, int fq) const {
#pragma unroll
        EPI_LOOP_AM {
            const int row = u.pm * 256 + ai * 128 + wr * 64 + m * 16 + fr;
            bf16* d = LST + ((size_t)u.pn * S5COLS_PAD + row) * 256;
#pragma unroll
            for (int bj = 0; bj < 2; ++bj) *(u32x4*)(d + bj * 128 + wc * 32 + 8 * fq) = pack8(acc[ai][bj][m][0], acc[ai][bj][m][1]);
        }
    }
};
struct EpiS5C {
    static constexpr bool PERM = true; static constexpr bool INPLACE = false;
    bf16* G;
    __device__ __forceinline__ void operator()(const f32x4 (&acc)[2][2][4][2], const Unit& u, int wr, int wc, int fr, int fq) const {
#pragma unroll
        EPI_LOOP_AM {
            const int col = u.pm * 256 + ai * 128 + wr * 64 + m * 16 + fr;
            if (col < S5COLS) {
                const int b = col / 272, cidx = col - b * 272;
                const int rowbase = (cidx < 16) ? (NX + b * 256 + 16 * cidx) : (b * 4096 + 16 * (cidx - 16));
#pragma unroll
                for (int bj = 0; bj < 2; ++bj) {
                    const int n0 = bj * 128 + wc * 32 + 8 * fq, tt = n0 >> 4, i0 = n0 & 15;
                    f32x4 v0 = acc[ai][bj][m][0], v1 = acc[ai][bj][m][1];
#pragma unroll
                    for (int j = 0; j < 4; ++j) { v0[j] = gelu_tanh_f(v0[j]); v1[j] = gelu_tanh_f(v1[j]); }
                    *(u32x4*)(G + (size_t)(rowbase + tt) * 1024 + 16 * u.pn + i0) = pack8(v0, v1);
                }
            }
        }
    }
};

#define XB_TMO      128
#define XB_XCNT(j)  (256  + 64 * (j))
#define XB_XSUB(j)  (1280 + 64 * (j))
#define XB_XGEN(j)  (2304 + 64 * (j))
#define XB_TOP      3328
#define XB_TOPGEN   3392
#define XCD_BAR_WORDS 3456
#define XB_SPIN_CAP (1u << 22)
__device__ __forceinline__ unsigned xb_ld(unsigned* p)              { return __hip_atomic_load(p, __ATOMIC_RELAXED, __HIP_MEMORY_SCOPE_AGENT); }
__device__ __forceinline__ unsigned xb_add(unsigned* p, unsigned v) { return __hip_atomic_fetch_add(p, v, __ATOMIC_RELAXED, __HIP_MEMORY_SCOPE_AGENT); }
__device__ __forceinline__ unsigned xb_xcc_id() { return (unsigned)__builtin_amdgcn_s_getreg((3 << 11) | 20) & 0xFu; }
#define XB_SPIN(cond, bar) do { unsigned _sp = 0; while (cond) { __builtin_amdgcn_s_sleep(1); \
    if ((++_sp & 255u) == 0u) { if (xb_ld(&(bar)[XB_TMO])) break; if (_sp > XB_SPIN_CAP) { atomicAdd(&(bar)[XB_TMO], 1u); break; } } } } while (0)
struct XcdBarrier { unsigned* bar; unsigned x; volatile LAS unsigned* st; };
__device__ __forceinline__ XcdBarrier xcd_barrier_post(unsigned* bar, volatile LAS unsigned* st) {
    XcdBarrier b; b.bar = bar; b.x = xb_xcc_id(); b.st = st;
    if (threadIdx.x == 0) (void)xb_add(&bar[XB_XCNT(b.x)], 1u);
    return b;
}
__device__ __forceinline__ void xcd_barrier_complete(unsigned* bar, unsigned x, unsigned& nloc, unsigned& nx) {
    const unsigned G = gridDim.x * gridDim.y * gridDim.z;
    unsigned sum, cnt, mine, sp = 0u;
    for (;;) {
        sum = 0u; cnt = 0u; mine = 0u;
#pragma unroll
        for (unsigned j = 0; j < 16; ++j) { const unsigned c = xb_ld(&bar[XB_XCNT(j)]); sum += c; cnt += (c > 0u) ? 1u : 0u; mine = (j == x) ? c : mine; }
        if (sum == G) break;
        __builtin_amdgcn_s_sleep(1);
        if ((++sp & 255u) == 0u) { if (xb_ld(&bar[XB_TMO])) break; if (sp > XB_SPIN_CAP) { atomicAdd(&bar[XB_TMO], 1u); break; } }
    }
    nloc = mine > 0u ? mine : 1u; nx = cnt > 0u ? cnt : 1u;
}
__device__ __forceinline__ void xcd_barrier(const XcdBarrier& b) {
    asm volatile("s_waitcnt vmcnt(0)" ::: "memory");
    __syncthreads();
    if (threadIdx.x == 0) {
        unsigned* bar = b.bar;
        __builtin_amdgcn_s_waitcnt(0);
        unsigned nloc = b.st[0], nx = b.st[1];
        if (nloc == 0u) { xcd_barrier_complete(bar, b.x, nloc, nx); b.st[0] = nloc; b.st[1] = nx; }
        const unsigned old = xb_add(&bar[XB_XSUB(b.x)], 1u);
        const unsigned gen = old / nloc;
        if (old + 1u == (gen + 1u) * nloc) {
            __builtin_amdgcn_fence(__ATOMIC_RELEASE, "agent");
            asm volatile("s_waitcnt vmcnt(0)" ::: "memory");
            const unsigned og = xb_add(&bar[XB_TOP], 1u);
            const unsigned tg = og / nx;
            if (og + 1u == (tg + 1u) * nx) xb_add(&bar[XB_TOPGEN], 1u);
            else XB_SPIN(xb_ld(&bar[XB_TOPGEN]) == tg, bar);
            __builtin_amdgcn_fence(__ATOMIC_ACQUIRE, "agent");
            xb_add(&bar[XB_XGEN(b.x)], 1u);
            asm volatile("s_waitcnt vmcnt(0)" ::: "memory");
        } else {
            XB_SPIN(xb_ld(&bar[XB_XGEN(b.x)]) == gen, bar);
            __builtin_amdgcn_fence(__ATOMIC_ACQUIRE, "agent");
            asm volatile("s_waitcnt vmcnt(0)" ::: "memory");
        }
    }
    __syncthreads();
}

struct Args { const float* in[32]; float* out; unsigned char* ws; int ph_lo, ph_hi, use_bar, pad; };
enum { I_X = 0, I_C, I_CTX, I_CCTX, I_ADAW, I_ADAB, I_N1G, I_N2G, I_WIN, I_WOUT, I_LRE, I_LIM, I_LDT, I_BRE, I_BIM, I_CRE, I_CIM, I_S5D, I_WGLU,
       I_GW2, I_GBG, I_GNG, I_WQKV, I_WNAO, I_QN, I_KN, I_RPB, I_RG, I_RE, I_MG, I_MU, I_MD };
struct Frame {
    LAS unsigned char* lds; int tid, lane, wave, vcu, G, gw, NGW;
};

__device__ __forceinline__ void transpose_item(const float* W, int ldw, bf16* WT, int ldt, int k0, int n0, int drow0, LAS float* scr, int lane) {
    float tv[32];
#pragma unroll
    for (int i = 0; i < 32; ++i) { const int kk = 2 * i + (lane >> 5); tv[i] = W[(size_t)(k0 + kk) * ldw + n0 + (lane & 31)]; }
#pragma unroll
    for (int i = 0; i < 32; ++i) { const int kk = 2 * i + (lane >> 5); scr[kk * 33 + (lane & 31)] = tv[i]; }
    LDS_WAIT(); asm volatile("" ::: "memory");
    const int c = lane & 7;
#pragma unroll
    for (int j = 0; j < 4; ++j) { const int n = (lane >> 3) + 8 * j; const LAS float* s = scr + (8 * c) * 33 + n;
        u32x4 o; o.x = pk2(s[0 * 33], s[1 * 33]); o.y = pk2(s[2 * 33], s[3 * 33]); o.z = pk2(s[4 * 33], s[5 * 33]); o.w = pk2(s[6 * 33], s[7 * 33]);
        *(u32x4*)(WT + (size_t)(drow0 + n) * ldt + k0 + 8 * c) = o; }
    LDS_WAIT(); asm volatile("" ::: "memory");
}
#ifndef CONV0_Q1
#define CONV0_Q1 800
#define CONV0_Q2 800
#endif
#define CONV0_LATE (CONV0_Q1 + CONV0_Q2)
#ifndef CONV0_MIXA
#define CONV0_MIXA 300
#endif
struct TrItem { const float* W; int ldw; bf16* WT; int ldt, k0, n0, drow0; };
__device__ __forceinline__ TrItem moe_item(const Args& a, int layer, int it) {
    bf16* WGU = (bf16*)(a.ws + WS_WGU); bf16* WD = (bf16*)(a.ws + WS_WD);
    const int e = it / 3072, r = it % 3072; const size_t le = (size_t)layer * NE + e; TrItem t;
    if (r < 2048) {
        const int up = r >> 10, q = r & 1023, pt = q >> 3, kb = 2 * (pt >> 3) + ((q >> 2) & 1), nb = 4 * (pt & 7) + (q & 3), n0 = nb * 32;
        t.W = (up ? a.in[I_MU] : a.in[I_MG]) + le * (size_t)(DM * MOEF); t.ldw = MOEF; t.WT = WGU + (size_t)e * (2048 * 2048); t.ldt = DM; t.k0 = kb * 64; t.n0 = n0; t.drow0 = 256 * (n0 >> 7) + (n0 & 127) + (up ? 128 : 0);
    } else {
        const int q = r - 2048, pt = q >> 3, kb = 2 * (pt >> 4) + ((q >> 2) & 1), nb = 4 * (pt & 15) + (q & 3);
        t.W = a.in[I_MD] + le * (size_t)(MOEF * DM); t.ldw = DM; t.WT = WD + (size_t)e * (2048 * 1024); t.ldt = MOEF; t.k0 = kb * 64; t.n0 = nb * 32; t.drow0 = nb * 32;
    }
    return t;
}
__device__ __forceinline__ void transpose_pair(const TrItem& A, const TrItem& B, bool hasB, LAS float* scrA, LAS float* scrB, int lane) {
    float ta[32], tb[32];
#pragma unroll
    for (int i = 0; i < 32; ++i) { const int kk = 2 * i + (lane >> 5); ta[i] = A.W[(size_t)(A.k0 + kk) * A.ldw + A.n0 + (lane & 31)]; }
#pragma unroll
    for (int i = 0; i < 32; ++i) { const int kk = 2 * i + (lane >> 5); tb[i] = B.W[(size_t)(B.k0 + kk) * B.ldw + B.n0 + (lane & 31)]; }
#pragma unroll
    for (int i = 0; i < 32; ++i) { const int kk = 2 * i + (lane >> 5); scrA[kk * 33 + (lane & 31)] = ta[i]; }
#pragma unroll
    for (int i = 0; i < 32; ++i) { const int kk = 2 * i + (lane >> 5); scrB[kk * 33 + (lane & 31)] = tb[i]; }
    LDS_WAIT(); asm volatile("" ::: "memory");
    const int c = lane & 7;
#pragma unroll
    for (int j = 0; j < 4; ++j) { const int n = (lane >> 3) + 8 * j; const LAS float* s = scrA + (8 * c) * 33 + n;
        u32x4 o; o.x = pk2(s[0 * 33], s[1 * 33]); o.y = pk2(s[2 * 33], s[3 * 33]); o.z = pk2(s[4 * 33], s[5 * 33]); o.w = pk2(s[6 * 33], s[7 * 33]);
        *(u32x4*)(A.WT + (size_t)(A.drow0 + n) * A.ldt + A.k0 + 8 * c) = o; }
    if (hasB) {
#pragma unroll
        for (int j = 0; j < 4; ++j) { const int n = (lane >> 3) + 8 * j; const LAS float* s = scrB + (8 * c) * 33 + n;
            u32x4 o; o.x = pk2(s[0 * 33], s[1 * 33]); o.y = pk2(s[2 * 33], s[3 * 33]); o.z = pk2(s[4 * 33], s[5 * 33]); o.w = pk2(s[6 * 33], s[7 * 33]);
            *(u32x4*)(B.WT + (size_t)(B.drow0 + n) * B.ldt + B.k0 + 8 * c) = o; }
    }
    LDS_WAIT(); asm volatile("" ::: "memory");
}
#ifndef CONV_PAIR
#define CONV_PAIR 1
#endif
#ifndef PROBE_CONV_REPS
#define PROBE_CONV_REPS 1
#endif
__device__ __forceinline__ void moe_convert_items_single(const Args& a, const Frame& F, int layer, int it0, int stride) {
    LAS float* scr = (LAS float*)(F.lds + F.wave * 16896);
    for (int it = it0; it < NE * 3072; it += stride) { const TrItem A = moe_item(a, layer, it); transpose_item(A.W, A.ldw, A.WT, A.ldt, A.k0, A.n0, A.drow0, scr, F.lane); }
}
__device__ __forceinline__ void moe_convert_items_pair(const Args& a, const Frame& F, int layer, int it0, int stride);
__device__ __forceinline__ void moe_convert_items(const Args& a, const Frame& F, int layer, int it0, int stride) {
#pragma nounroll
    for (int rep = 0; rep < PROBE_CONV_REPS; ++rep) { if (CONV_PAIR) moe_convert_items_pair(a, F, layer, it0, stride); else moe_convert_items_single(a, F, layer, it0, stride); }
}
__device__ __forceinline__ void tp_load(const TrItem& A, const TrItem& B, float (&ta)[32], float (&tb)[32], int lane) {
#pragma unroll
    for (int i = 0; i < 32; ++i) { const int kk = 2 * i + (lane >> 5); ta[i] = A.W[(size_t)(A.k0 + kk) * A.ldw + A.n0 + (lane & 31)]; }
#pragma unroll
    for (int i = 0; i < 32; ++i) { const int kk = 2 * i + (lane >> 5); tb[i] = B.W[(size_t)(B.k0 + kk) * B.ldw + B.n0 + (lane & 31)]; }
}
__device__ __forceinline__ void tp_finish(const TrItem& A, const TrItem& B, const float (&ta)[32], const float (&tb)[32], LAS float* scrA, LAS float* scrB, int lane) {
#pragma unroll
    for (int i = 0; i < 32; ++i) { const int kk = 2 * i + (lane >> 5); scrA[kk * 33 + (lane & 31)] = ta[i]; }
#pragma unroll
    for (int i = 0; i < 32; ++i) { const int kk = 2 * i + (lane >> 5); scrB[kk * 33 + (lane & 31)] = tb[i]; }
    LDS_WAIT(); asm volatile("" ::: "memory");
    const int c = lane & 7;
#pragma unroll
    for (int j = 0; j < 4; ++j) { const int n = (lane >> 3) + 8 * j; const LAS float* s = scrA + (8 * c) * 33 + n;
        u32x4 o; o.x = pk2(s[0 * 33], s[1 * 33]); o.y = pk2(s[2 * 33], s[3 * 33]); o.z = pk2(s[4 * 33], s[5 * 33]); o.w = pk2(s[6 * 33], s[7 * 33]);
        *(u32x4*)(A.WT + (size_t)(A.drow0 + n) * A.ldt + A.k0 + 8 * c) = o; }
#pragma unroll
    for (int j = 0; j < 4; ++j) { const int n = (lane >> 3) + 8 * j; const LAS float* s = scrB + (8 * c) * 33 + n;
        u32x4 o; o.x = pk2(s[0 * 33], s[1 * 33]); o.y = pk2(s[2 * 33], s[3 * 33]); o.z = pk2(s[4 * 33], s[5 * 33]); o.w = pk2(s[6 * 33], s[7 * 33]);
        *(u32x4*)(B.WT + (size_t)(B.drow0 + n) * B.ldt + B.k0 + 8 * c) = o; }
    LDS_WAIT(); asm volatile("" ::: "memory");
}
__device__ __forceinline__ void moe_convert_dyn(const Args& a, const Frame& F0, int layer, unsigned* ctr, int base = 0, int NCH = NE * 3072 / 32) {
    Frame F = F0; asm volatile("" : "+v"(F.tid), "+v"(F.lane));
    F.wave = __builtin_amdgcn_readfirstlane(F.tid >> 6);
    LAS float* scrA = (LAS float*)(F.lds + F.wave * 16896); LAS float* scrB = scrA + 64 * 33;
    volatile LAS int* slot = (volatile LAS int*)(F.lds + LDS_MISC) + 20;
    __syncthreads(); if (F.tid == 0) slot[0] = (int)atomicAdd(ctr, 1u); __syncthreads();
    int c = __builtin_amdgcn_readfirstlane(slot[0]), par = 1, nxt = 0;
    if (c < NCH) {
        float r0a[32], r0b[32], r1a[32], r1b[32];
        if (F.tid == 0) nxt = (int)atomicAdd(ctr, 1u);
        { const TrItem A = moe_item(a, layer, (base + c) * 32 + F.wave), B = moe_item(a, layer, (base + c) * 32 + 8 + F.wave); tp_load(A, B, r0a, r0b, F.lane); }
        for (;;) {
            { const TrItem A = moe_item(a, layer, (base + c) * 32 + 16 + F.wave), B = moe_item(a, layer, (base + c) * 32 + 24 + F.wave); tp_load(A, B, r1a, r1b, F.lane); }
            { const TrItem A = moe_item(a, layer, (base + c) * 32 + F.wave), B = moe_item(a, layer, (base + c) * 32 + 8 + F.wave); tp_finish(A, B, r0a, r0b, scrA, scrB, F.lane); }
            if (F.tid == 0) slot[par] = nxt;
            __syncthreads(); const int cn = __builtin_amdgcn_readfirstlane(slot[par]); par ^= 1;
            if (F.tid == 0) nxt = (int)atomicAdd(ctr, 1u);
            if (cn < NCH) { const TrItem A = moe_item(a, layer, (base + cn) * 32 + F.wave), B = moe_item(a, layer, (base + cn) * 32 + 8 + F.wave); tp_load(A, B, r0a, r0b, F.lane); }
            { const TrItem A = moe_item(a, layer, (base + c) * 32 + 16 + F.wave), B = moe_item(a, layer, (base + c) * 32 + 24 + F.wave); tp_finish(A, B, r1a, r1b, scrA, scrB, F.lane); }
            if (cn >= NCH) break;
            c = cn;
        }
    }
    __syncthreads();
}
__device__ __forceinline__ void moe_convert_items_pair(const Args& a, const Frame& F, int layer, int it0, int stride) {
    LAS float* scrA = (LAS float*)(F.lds + F.wave * 16896); LAS float* scrB = scrA + 64 * 33;
    for (int it = it0; it < NE * 3072; it += 2 * stride) {
        const int it2 = it + stride; const bool hasB = it2 < NE * 3072;
        const TrItem A = moe_item(a, layer, it), B = moe_item(a, layer, hasB ? it2 : it);
        transpose_pair(A, B, hasB, scrA, scrB, F.lane);
    }
}
__device__ __forceinline__ void s5_build_consts(const Args& a, const Frame& F);
__device__ __forceinline__ void p0_prologue(const Args& a, const Frame& F) {
    LAS float* scr = (LAS float*)(F.lds + F.wave * 16896);
    constexpr int I_IN = 32 * 129, I_GLU = 16 * 32, I_OUT = 32 * 64, I_QKV = 32 * 192, I_NAO = 32 * 64, NIT = I_IN + I_GLU + I_OUT + I_QKV + I_NAO;
    for (int it = F.gw; it < NIT; it += F.NGW) {
        int r = it;
        if (r < I_IN) { transpose_item(a.in[I_WIN], AB_IN, (bf16*)(a.ws + WS_WIN), DM, (r / 129) * 64, (r % 129) * 32, (r % 129) * 32, scr, F.lane); continue; } r -= I_IN;
        if (r < I_GLU) { transpose_item(a.in[I_WGLU], 1024, (bf16*)(a.ws + WS_WGLU), 1024, (r / 32) * 64, (r % 32) * 32, (r % 32) * 32, scr, F.lane); continue; } r -= I_GLU;
        if (r < I_OUT) { transpose_item(a.in[I_WOUT], DM, (bf16*)(a.ws + WS_WOUT), DM, (r / 64) * 64, (r % 64) * 32, (r % 64) * 32, scr, F.lane); continue; } r -= I_OUT;
        if (r < I_QKV) { transpose_item(a.in[I_WQKV], 3 * DM, (bf16*)(a.ws + WS_WQKV), DM, (r / 192) * 64, (r % 192) * 32, (r % 192) * 32, scr, F.lane); continue; } r -= I_QKV;
        transpose_item(a.in[I_WNAO], DM, (bf16*)(a.ws + WS_WNAO), DM, (r / 64) * 64, (r % 64) * 32, (r % 64) * 32, scr, F.lane);
    }
    for (int i = F.gw * 64 + F.lane; i < 2 * 36 * DM; i += F.NGW * 64) {
        const int l = i / (36 * DM), r = i % (36 * DM), n = r / DM, k = r % DM;
        const float v = n < 4 ? a.in[I_RG][((size_t)l * DM + k) * 4 + n] : a.in[I_RE][((size_t)l * DM + k) * 32 + (n - 4)];
        ((bf16*)(a.ws + WS_WR))[((size_t)l * 256 + n) * DM + k] = (bf16)f2bf(v);
    }
    __syncthreads();
    s5_build_consts(a, F);
    {
        LAS float* sv = (LAS float*)F.lds;
        LAS float* red = (LAS float*)(F.lds + 65536);
#pragma unroll
        for (int it = 0; it < 20; ++it) { const int i = F.tid + 512 * it, r = i / DM, k = i % DM; const float cv = r < 4 ? a.in[I_C][r * DM + k] : a.in[I_CCTX][k]; sv[i] = silu_f(cv); }
        __syncthreads();
        float* MOD = (float*)(a.ws + WS_MOD);
        for (int item = F.vcu; item < 2 * 192; item += F.G) {
            const int l = item / 192, n = (item % 192) * 64 + F.lane;
            const float* W = a.in[I_ADAW] + (size_t)l * DM * MODW + n;
            float acc[5] = {0.f, 0.f, 0.f, 0.f, 0.f};
            for (int j0 = 0; j0 < 256; j0 += 32) {
                float wv[32];
#pragma unroll
                for (int j = 0; j < 32; ++j) wv[j] = W[(size_t)(F.wave + 8 * (j0 + j)) * MODW];
#pragma unroll
                for (int j = 0; j < 32; ++j) { const int k = F.wave + 8 * (j0 + j);
#pragma unroll
                    for (int r = 0; r < 5; ++r) acc[r] += sv[r * DM + k] * wv[j]; }
            }
#pragma unroll
            for (int r = 0; r < 5; ++r) red[(F.wave * 5 + r) * 64 + F.lane] = acc[r];
            __syncthreads();
            if (F.tid < 320) { const int r = F.tid >> 6; float s = a.in[I_ADAB][l * MODW + n];
#pragma unroll
                for (int w = 0; w < 8; ++w) s += red[(w * 5 + r) * 64 + F.lane];
                MOD[((size_t)l * 5 + r) * MODW + n] = s; }
            __syncthreads();
        }
    }
    moe_convert_dyn(a, F, 0, (unsigned*)(a.ws + WS_CTL) + CW_QC0 + 64, CONV0_LATE + CONV0_MIXA, NE * 3072 / 32 - CONV0_LATE - CONV0_MIXA);
}

__device__ __forceinline__ void modulate_store(const f32x4 (&v)[8], const float* gain, const float* shift, const float* scale, bf16* orow, int lane) {
    float s2 = 0.f;
#pragma unroll
    for (int j = 0; j < 8; ++j) s2 += (v[j].x * v[j].x + v[j].y * v[j].y) + (v[j].z * v[j].z + v[j].w * v[j].w);
    const float rstd = rsqrtf(wave_sum(s2) * (1.f / DM) + EPS);
#pragma unroll
    for (int j = 0; j < 8; ++j) {
        const int c = 4 * lane + 256 * j;
        const f32x4 g = *(const f32x4*)(gain + c), sh = *(const f32x4*)(shift + c), sc = *(const f32x4*)(scale + c);
        const f32x4 y = v[j] * rstd * g * (sc + 1.0f) + sh;
        u32x2 w; w.x = pk2(y.x, y.y); w.y = pk2(y.z, y.w);
        *(u32x2*)(orow + c) = w;
    }
}
__device__ __forceinline__ void modulate_store_lds(const f32x4 (&v)[8], const LAS float* gain, const LAS float* shift, const LAS float* scale, bf16* orow, int lane) {
    float s2 = 0.f;
#pragma unroll
    for (int j = 0; j < 8; ++j) s2 += (v[j].x * v[j].x + v[j].y * v[j].y) + (v[j].z * v[j].z + v[j].w * v[j].w);
    const float rstd = rsqrtf(wave_sum(s2) * (1.f / DM) + EPS);
#pragma unroll
    for (int j = 0; j < 8; ++j) {
        const int c = 4 * lane + 256 * j;
        const f32x4 g = *(const LAS f32x4*)(gain + c), sh = *(const LAS f32x4*)(shift + c), sc = *(const LAS f32x4*)(scale + c);
        const f32x4 y = v[j] * rstd * g * (sc + 1.0f) + sh;
        u32x2 w; w.x = pk2(y.x, y.y); w.y = pk2(y.z, y.w);
        *(u32x2*)(orow + c) = w;
    }
}
__device__ __forceinline__ void stage_mod_lds(LAS float* dst, const float* gain, const float* modrow0, int shift_off, int scale_off, int tid) {
    for (int i = tid; i < DM / 4; i += 512) *(LAS f32x4*)(dst + 4 * i) = *(const f32x4*)(gain + 4 * i);
    for (int i = tid; i < 5 * DM / 4; i += 512) { const int r = i / (DM / 4), c = (i % (DM / 4)) * 4;
        *(LAS f32x4*)(dst + DM + (2 * r) * DM + c) = *(const f32x4*)(modrow0 + (size_t)r * MODW + shift_off + c);
        *(LAS f32x4*)(dst + DM + (2 * r + 1) * DM + c) = *(const f32x4*)(modrow0 + (size_t)r * MODW + scale_off + c); }
}
__device__ __forceinline__ void load_row_bf16(const bf16* p, f32x4 (&v)[8], int lane) {
#pragma unroll
    for (int j = 0; j < 8; ++j) { const u32x2 w = *(const u32x2*)(p + 4 * lane + 256 * j); v[j] = (f32x4){bflo(w.x), bfhi(w.x), bflo(w.y), bfhi(w.y)}; }
}
__device__ __forceinline__ void store_row_bf16(bf16* p, const f32x4 (&v)[8], int lane) {
#pragma unroll
    for (int j = 0; j < 8; ++j) { u32x2 w; w.x = pk2(v[j].x, v[j].y); w.y = pk2(v[j].z, v[j].w); *(u32x2*)(p + 4 * lane + 256 * j) = w; }
}
__device__ __forceinline__ void load_row(const float* p, f32x4 (&v)[8], int lane) {
#pragma unroll
    for (int j = 0; j < 8; ++j) v[j] = *(const f32x4*)(p + 4 * lane + 256 * j);
}

__device__ __forceinline__ float log_sigmoid_f(float z) { return fminf(z, 0.f) - log1pf(__expf(-fabsf(z))); }
__device__ __forceinline__ void gla_prep(const Args& a, const Frame& F) {
    bf16* GQ = (bf16*)(a.ws + WS_GQ); bf16* GK = (bf16*)(a.ws + WS_GK); const float* LOWR = (const float*)(a.ws + WS_LOWR); bf16* LA = (bf16*)(a.ws + WS_LA);
    LAS float* W2s = (LAS float*)F.lds;
    const int lane = F.lane;
    __syncthreads();
#pragma unroll
    for (int it = 0; it < 8; ++it) { const int i = F.tid + 512 * it; *(LAS f32x4*)(W2s + 4 * i) = *(const f32x4*)(a.in[I_GW2] + 4 * i); }
    __syncthreads();
    const float* BG = a.in[I_GBG];
    const int fbase = 8 * (lane & 3); const bool second = (lane & 4) != 0; const int half = (lane & 15) >> 3;
    float inv[8];
#pragma unroll
    for (int j = 0; j < 8; ++j) inv[j] = exp2f(-(float)(fbase + j) * (13.287712379549449f / 32.0f));
    for (int row = F.gw; row < MT; row += F.NGW) {
        int isctx, b, t; row_decode(row, isctx, b, t);
        const u32x4 qw = *(const u32x4*)(GQ + (size_t)row * 512 + 8 * lane), kw = *(const u32x4*)(GK + (size_t)row * 512 + 8 * lane);
        float q[8] = {bflo(qw.x), bfhi(qw.x), bflo(qw.y), bfhi(qw.y), bflo(qw.z), bfhi(qw.z), bflo(qw.w), bfhi(qw.w)};
        float k[8] = {bflo(kw.x), bfhi(kw.x), bflo(kw.y), bfhi(kw.y), bflo(kw.z), bfhi(kw.z), bflo(kw.w), bfhi(kw.w)};
        if (!isctx) {
            const float pos = (float)(half ? (t & 63) : (t >> 6));
#pragma unroll
            for (int j = 0; j < 8; ++j) { const float ang = pos * inv[j], s = __sinf(ang), c = __cosf(ang);
                const float pq = __shfl_xor(q[j], 4), pk = __shfl_xor(k[j], 4);
                q[j] = second ? pq * s + q[j] * c : q[j] * c - pq * s; k[j] = second ? pk * s + k[j] * c : k[j] * c - pk * s; }
        }
        const float qs = 0.08838834764831845f;
        u32x4 qo, ko; qo.x = pk2(q[0] * qs, q[1] * qs); qo.y = pk2(q[2] * qs, q[3] * qs); qo.z = pk2(q[4] * qs, q[5] * qs); qo.w = pk2(q[6] * qs, q[7] * qs);
        ko.x = pk2(k[0], k[1]); ko.y = pk2(k[2], k[3]); ko.z = pk2(k[4], k[5]); ko.w = pk2(k[6], k[7]);
        *(u32x4*)(GQ + (size_t)row * 512 + 8 * lane) = qo; *(u32x4*)(GK + (size_t)row * 512 + 8 * lane) = ko;
#pragma nounroll
        for (int d = 0; d < 2; ++d) {
            f32x4 z0 = *(const f32x4*)(BG + d * 512 + 8 * lane), z1 = *(const f32x4*)(BG + d * 512 + 8 * lane + 4);
#pragma unroll 4
            for (int jj = 0; jj < 16; ++jj) { const float lr = LOWR[(size_t)row * 32 + d * 16 + jj]; const LAS float* w = W2s + (d * 16 + jj) * 512 + 8 * lane;
                z0 += *(const LAS f32x4*)w * lr; z1 += *(const LAS f32x4*)(w + 4) * lr; }
            f32x4 o0, o1;
#pragma unroll
            for (int j = 0; j < 4; ++j) { o0[j] = log_sigmoid_f(z0[j]) * (1.0f / 16.0f); o1[j] = log_sigmoid_f(z1[j]) * (1.0f / 16.0f); }
            *(u32x4*)(LA + ((size_t)d * MT + row) * 512 + 8 * lane) = pack8(o0, o1);
        }
    }
    __syncthreads();
}

__device__ __forceinline__ void s5_naive(const Args& a, const Frame& F) {
    const bf16* GU = (const bf16*)(a.ws + WS_UEXT); float* YD = (float*)(a.ws + WS_YD);
    const int lane = F.lane;
    for (int item = F.gw; item < NB * S5G * 2; item += F.NGW) {
        const int dir = item & 1, g = (item >> 1) & 63, b = item >> 7;
        const size_t po = ((size_t)dir * S5G + g) * S5P + lane;
        const float lr = fminf(a.in[I_LRE][po], -1e-4f), li = a.in[I_LIM][po], dt = expf(a.in[I_LDT][dir * S5G + g]);
        const float mag = expf(lr * dt); float sn, cs; sincosf(li * dt, &sn, &cs);
        const float ar = mag * cs, ai = mag * sn, nr = ar - 1.0f, den = lr * lr + li * li;
        const float fr = (nr * lr + ai * li) / den, fi = (ai * lr - nr * li) / den;
        float btr[16], bti[16], cr[16], ci[16];
#pragma unroll
        for (int j = 0; j < 16; ++j) { const float br = a.in[I_BRE][po * 16 + j], bi = a.in[I_BIM][po * 16 + j]; btr[j] = fr * br - fi * bi; bti[j] = fr * bi + fi * br;
            cr[j] = a.in[I_CRE][(((size_t)dir * S5G + g) * 16 + j) * S5P + lane]; ci[j] = a.in[I_CIM][(((size_t)dir * S5G + g) * 16 + j) * S5P + lane]; }
        float hr = 0.f, hi = 0.f;
        for (int step = 0; step < CTX + SEQ; ++step) {
            int row;
            if (step < CTX) row = NX + b * CTX + (dir ? (CTX - 1 - step) : step);
            else { const int s = step - CTX; row = b * SEQ + (dir ? (SEQ - 1 - s) : s); }
            const u32x4 u0 = *(const u32x4*)(GU + (size_t)row * 1024 + 16 * g), u1 = *(const u32x4*)(GU + (size_t)row * 1024 + 16 * g + 8);
            float uv[16] = {bflo(u0.x), bfhi(u0.x), bflo(u0.y), bfhi(u0.y), bflo(u0.z), bfhi(u0.z), bflo(u0.w), bfhi(u0.w),
                            bflo(u1.x), bfhi(u1.x), bflo(u1.y), bfhi(u1.y), bflo(u1.z), bfhi(u1.z), bflo(u1.w), bfhi(u1.w)};
            float xr = 0.f, xi = 0.f;
#pragma unroll
            for (int j = 0; j < 16; ++j) { xr += btr[j] * uv[j]; xi += bti[j] * uv[j]; }
            const float nhr = ar * hr - ai * hi + xr, nhi = ar * hi + ai * hr + xi; hr = nhr; hi = nhi;
            float yv = 0.f;
#pragma unroll
            for (int i = 0; i < 16; ++i) { const float y = wave_sum(cr[i] * hr - ci[i] * hi); yv = (lane == i) ? y : yv; }
            if (lane < 16) YD[((size_t)dir * MT + row) * 1024 + 16 * g + lane] = yv;
        }
    }
}
__device__ __forceinline__ void s5_finish_naive(const Args& a, const Frame& F) {
    const bf16* GU = (const bf16*)(a.ws + WS_UEXT); const float* YD = (const float*)(a.ws + WS_YD); bf16* G = (bf16*)(a.ws + WS_G);
    for (size_t i = (size_t)F.gw * 64 + F.lane; i < (size_t)MT * 256; i += (size_t)F.NGW * 64) {
        const size_t e = i * 4; const int c = (int)(e & 1023);
        const f32x4 yf = *(const f32x4*)(YD + e), yb = *(const f32x4*)(YD + (size_t)MT * 1024 + e), dk = *(const f32x4*)(a.in[I_S5D] + c);
        const u32x2 uw = *(const u32x2*)(GU + e);
        const float y0 = yf.x + yb.x + dk.x * bflo(uw.x), y1 = yf.y + yb.y + dk.y * bfhi(uw.x), y2 = yf.z + yb.z + dk.z * bflo(uw.y), y3 = yf.w + yb.w + dk.w * bfhi(uw.y);
        u32x2 o; o.x = pk2(gelu_tanh_f(y0), gelu_tanh_f(y1)); o.y = pk2(gelu_tanh_f(y2), gelu_tanh_f(y3));
        *(u32x2*)(G + e) = o;
    }
}


__device__ __forceinline__ void s5_build_consts(const Args& a, const Frame& F) {
    LAS float* pw = (LAS float*)F.lds;
    LAS float* bt = pw + 2 * 64 * 17 * 2;
    LAS float* cc = bt + 2 * 64 * 16 * 2;
    LAS float* Kt = cc + 2 * 16 * 64 * 2;
    bf16* SM = (bf16*)(a.ws + WS_SM); bf16* SE = (bf16*)(a.ws + WS_SE);
    for (int g = F.vcu; g < S5G; g += F.G) {
        __syncthreads();
        if (F.tid < 128) {
            const int dir = F.tid >> 6, p = F.tid & 63; const size_t po = ((size_t)dir * S5G + g) * S5P + p;
            const float lr = fminf(a.in[I_LRE][po], -1e-4f), li = a.in[I_LIM][po], dt = expf(a.in[I_LDT][dir * S5G + g]);
            const float mag = expf(lr * dt); float sn, cs; sincosf(li * dt, &sn, &cs);
            const float ar = mag * cs, ai = mag * sn, nr = ar - 1.0f, den = lr * lr + li * li;
            const float fr = (nr * lr + ai * li) / den, fi = (ai * lr - nr * li) / den;
            for (int n = 0; n <= 16; ++n) { const float m = expf((float)n * lr * dt); float s1, c1; sincosf((float)n * li * dt, &s1, &c1); pw[((dir * 64 + p) * 17 + n) * 2] = m * c1; pw[((dir * 64 + p) * 17 + n) * 2 + 1] = m * s1; }
            for (int j = 0; j < 16; ++j) { const float br = a.in[I_BRE][po * 16 + j], bi = a.in[I_BIM][po * 16 + j]; bt[((dir * 64 + p) * 16 + j) * 2] = fr * br - fi * bi; bt[((dir * 64 + p) * 16 + j) * 2 + 1] = fr * bi + fi * br; }
        }
        for (int i = F.tid; i < 2 * 16 * 64; i += 512) { const int dir = i >> 10, r = i & 1023; const size_t co = ((size_t)dir * S5G + g) * 1024 + r; cc[i * 2] = a.in[I_CRE][co]; cc[i * 2 + 1] = a.in[I_CIM][co]; }
        __syncthreads();
        {
            const int dir = F.tid >> 8, tau = (F.tid >> 4) & 15, i = F.tid & 15;
            float acc[16];
#pragma unroll
            for (int j = 0; j < 16; ++j) acc[j] = 0.f;
            for (int p = 0; p < 64; ++p) {
                const float cr = cc[((dir * 16 + i) * 64 + p) * 2], ci = cc[((dir * 16 + i) * 64 + p) * 2 + 1];
                const float pr = pw[((dir * 64 + p) * 17 + tau) * 2], pi = pw[((dir * 64 + p) * 17 + tau) * 2 + 1];
                const float wr = cr * pr - ci * pi, wi = cr * pi + ci * pr;
#pragma unroll
                for (int j = 0; j < 16; ++j) acc[j] += wr * bt[((dir * 64 + p) * 16 + j) * 2] - wi * bt[((dir * 64 + p) * 16 + j) * 2 + 1];
            }
#pragma unroll
            for (int j = 0; j < 16; ++j) Kt[((dir * 16 + tau) * 16 + i) * 16 + j] = acc[j];
        }
        __syncthreads();
        {
            const int n = F.tid >> 1, half = F.tid & 1, t = n >> 4, i = n & 15;
            bf16* dst = SM + ((size_t)g * 256 + n) * 512 + half * 256;
            for (int k8 = 0; k8 < 32; ++k8) {
                float v[8];
#pragma unroll
                for (int e = 0; e < 8; ++e) {
                    const int k = k8 * 8 + e;
                    if (half == 0) { const int s = k >> 4, j = k & 15;
                        if (s < t) v[e] = Kt[((0 * 16 + (t - s)) * 16 + i) * 16 + j];
                        else if (s > t) v[e] = Kt[((1 * 16 + (s - t)) * 16 + i) * 16 + j];
                        else v[e] = Kt[((0 * 16 + 0) * 16 + i) * 16 + j] + Kt[((1 * 16 + 0) * 16 + i) * 16 + j] + (i == j ? a.in[I_S5D][16 * g + i] : 0.f);
                    } else { const int q = k >> 6, p = k & 63, dir = q >> 1, pn = dir == 0 ? t + 1 : 16 - t;
                        const float cr = cc[((dir * 16 + i) * 64 + p) * 2], ci = cc[((dir * 16 + i) * 64 + p) * 2 + 1];
                        const float pr = pw[((dir * 64 + p) * 17 + pn) * 2], pi = pw[((dir * 64 + p) * 17 + pn) * 2 + 1];
                        v[e] = (q & 1) ? -(cr * pi + ci * pr) : (cr * pr - ci * pi); }
                }
                u32x4 o; o.x = pk2(v[0], v[1]); o.y = pk2(v[2], v[3]); o.z = pk2(v[4], v[5]); o.w = pk2(v[6], v[7]);
                *(u32x4*)(dst + k8 * 8) = o;
            }
        }
        {
            const int n = F.tid >> 1, half = F.tid & 1, q = n >> 6, p = n & 63, dir = q >> 1;
            bf16* dst = SE + ((size_t)g * 256 + n) * 256 + half * 128;
            for (int k8 = 0; k8 < 16; ++k8) {
                float v[8];
#pragma unroll
                for (int e = 0; e < 8; ++e) {
                    const int k = half * 128 + k8 * 8 + e, s = k >> 4, j = k & 15, pn = dir == 0 ? 15 - s : s;
                    const float pr = pw[((dir * 64 + p) * 17 + pn) * 2], pi = pw[((dir * 64 + p) * 17 + pn) * 2 + 1];
                    const float br = bt[((dir * 64 + p) * 16 + j) * 2], bi = bt[((dir * 64 + p) * 16 + j) * 2 + 1];
                    v[e] = (q & 1) ? (pr * bi + pi * br) : (pr * br - pi * bi);
                }
                u32x4 o; o.x = pk2(v[0], v[1]); o.y = pk2(v[2], v[3]); o.z = pk2(v[4], v[5]); o.w = pk2(v[6], v[7]);
                *(u32x4*)(dst + k8 * 8) = o;
            }
        }
    }
    __syncthreads();
}
__device__ __forceinline__ void s5_scan(const Args& a, const Frame& F) {
    const bf16* LST = (const bf16*)(a.ws + WS_LST); bf16* UEXT = (bf16*)(a.ws + WS_UEXT);
    for (int item = F.gw; item < S5G * NB * 2; item += F.NGW) {
        const int dir = item & 1, b = (item >> 1) & 3, g = item >> 3, p = F.lane;
        const size_t po = ((size_t)dir * S5G + g) * S5P + p;
        const float lr = fminf(a.in[I_LRE][po], -1e-4f), li = a.in[I_LIM][po], dt = expf(a.in[I_LDT][dir * S5G + g]);
        const float mag = expf(16.0f * lr * dt); float sn, cs; sincosf(16.0f * li * dt, &sn, &cs);
        const float ar = mag * cs, ai = mag * sn;
        float hr = 0.f, hi = 0.f;
        const size_t colbase = (size_t)g * S5COLS_PAD + b * 272;
        for (int c0 = 0; c0 < 272; c0 += 16) {
            float lre[16], lim[16];
#pragma unroll
            for (int j = 0; j < 16; ++j) { const int c = c0 + j, cidx = dir == 0 ? c : (c < 16 ? 15 - c : 287 - c);
                const bf16* lp = LST + (colbase + cidx) * 256 + dir * 128 + p; lre[j] = bf2f(lp[0]); lim[j] = bf2f(lp[64]); }
#pragma unroll
            for (int j = 0; j < 16; ++j) { const int c = c0 + j, cidx = dir == 0 ? c : (c < 16 ? 15 - c : 287 - c);
                bf16* up = UEXT + (colbase + cidx) * 512 + 256 + dir * 128 + p;
                up[0] = (bf16)f2bf(hr); up[64] = (bf16)f2bf(hi);
                const float nhr = ar * hr - ai * hi + lre[j], nhi = ar * hi + ai * hr + lim[j]; hr = nhr; hi = nhi; }
        }
    }
}

__device__ __forceinline__ void gla_naive(const Args& a, const Frame& F) {
    const bf16* GQ = (const bf16*)(a.ws + WS_GQ); const bf16* GK = (const bf16*)(a.ws + WS_GK); const bf16* GV = (const bf16*)(a.ws + WS_GV);
    const float* LA = (const float*)(a.ws + WS_LA); float* OD = (float*)(a.ws + WS_UC);
    LAS float* red = (LAS float*)F.lds;
    const int e = F.tid & 31, dg = F.tid >> 5;
    for (int item = F.vcu; item < NB * GH * 2 * 8; item += F.G) {
        const int es = item & 7, dir = (item >> 3) & 1, h = (item >> 4) & 3, b = item >> 6;
        float S[8];
#pragma unroll
        for (int j = 0; j < 8; ++j) S[j] = 0.f;
        int prow = -1;
        for (int step = 0; step < CTX + SEQ; ++step) {
            int row;
            if (step < CTX) row = NX + b * CTX + (dir ? (CTX - 1 - step) : step);
            else { const int s = step - CTX; row = b * SEQ + (dir ? (SEQ - 1 - s) : s); }
            const size_t qo = (size_t)row * 512 + h * 128 + dg * 8;
            const u32x4 qw = *(const u32x4*)(GQ + qo), kw = *(const u32x4*)(GK + qo);
            const f32x4 la0 = *(const f32x4*)(LA + ((size_t)dir * MT + row) * 512 + h * 128 + dg * 8), la1 = *(const f32x4*)(LA + ((size_t)dir * MT + row) * 512 + h * 128 + dg * 8 + 4);
            const float v = bf2f(GV[(size_t)row * 1024 + h * 256 + es * 32 + e]);
            const float qv[8] = {bflo(qw.x), bfhi(qw.x), bflo(qw.y), bfhi(qw.y), bflo(qw.z), bfhi(qw.z), bflo(qw.w), bfhi(qw.w)};
            const float kv[8] = {bflo(kw.x), bfhi(kw.x), bflo(kw.y), bfhi(kw.y), bflo(kw.z), bfhi(kw.z), bflo(kw.w), bfhi(kw.w)};
            const float lv[8] = {la0.x, la0.y, la0.z, la0.w, la1.x, la1.y, la1.z, la1.w};
            float part = 0.f;
#pragma unroll
            for (int j = 0; j < 8; ++j) { S[j] = __expf(lv[j]) * S[j] + kv[j] * v; part += qv[j] * S[j]; }
            red[((step & 1) * 16 + dg) * 32 + e] = part;
            __syncthreads();
            if (F.tid < 32) { float o = 0.f;
#pragma unroll
                for (int w = 0; w < 16; ++w) o += red[((step & 1) * 16 + w) * 32 + e];
                OD[((size_t)dir * MT + row) * 1024 + h * 256 + es * 32 + e] = o; }
            (void)prow;
        }
        __syncthreads();
    }
}
__device__ __forceinline__ void gla_finish_naive(const Args& a, const Frame& F) {
    const float* OD = (const float*)(a.ws + WS_UC); const bf16* GR = (const bf16*)(a.ws + WS_GR); bf16* AB = (bf16*)(a.ws + WS_AB);
    for (int item = F.gw; item < MT * GH; item += F.NGW) {
        const int row = item >> 2, h = item & 3; const size_t o = (size_t)row * 1024 + h * 256 + 4 * F.lane;
        const f32x4 v = *(const f32x4*)(OD + o) + *(const f32x4*)(OD + (size_t)MT * 1024 + o);
        const float rstd = rsqrtf(wave_sum((v.x * v.x + v.y * v.y) + (v.z * v.z + v.w * v.w)) * (1.f / 256.f) + EPS);
        const f32x4 g = *(const f32x4*)(a.in[I_GNG] + h * 256 + 4 * F.lane); const u32x2 rw = *(const u32x2*)(GR + o);
        u32x2 w; w.x = pk2(v.x * rstd * g.x * silu_f(bflo(rw.x)), v.y * rstd * g.y * silu_f(bfhi(rw.x))); w.y = pk2(v.z * rstd * g.z * silu_f(bflo(rw.y)), v.w * rstd * g.w * silu_f(bfhi(rw.y)));
        *(u32x2*)(AB + (size_t)row * 2048 + 1024 + h * 256 + 4 * F.lane) = w;
    }
}


__device__ __forceinline__ float scan_incl(float v, int lane, bool suffix) {
#pragma unroll
    for (int o = 1; o < 64; o <<= 1) { const float u = suffix ? __shfl_down(v, o) : __shfl_up(v, o); const bool ok = suffix ? (lane + o < 64) : (lane >= o); v += ok ? u : 0.f; }
    return v;
}
template <int CTRL, int ROWMASK, bool BOUND> __device__ __forceinline__ float dpp_mov0(float x) {
    return __builtin_bit_cast(float, __builtin_amdgcn_update_dpp(0, __builtin_bit_cast(int, x), CTRL, ROWMASK, 0xF, BOUND)); }
__device__ __forceinline__ float prefix_incl_dpp(float v) {
    v += dpp_mov0<0x111, 0xF, true>(v); v += dpp_mov0<0x112, 0xF, true>(v); v += dpp_mov0<0x114, 0xF, true>(v); v += dpp_mov0<0x118, 0xF, true>(v);
    v += dpp_mov0<0x142, 0xA, false>(v);
    v += dpp_mov0<0x143, 0xC, false>(v);
    return v;
}
__device__ __forceinline__ float lane_bcast(float x, int srclane);
template <int N, bool SUFFIX> __device__ __forceinline__ void scan_vec(float (&v)[N], int lane) {
#pragma unroll
    for (int j = 0; j < N; ++j) { const float x = v[j], p = prefix_incl_dpp(x); v[j] = SUFFIX ? (lane_bcast(p, 63) - p) + x : p; }
}
__device__ __forceinline__ float lane_bcast(float x, int srclane) { return __builtin_bit_cast(float, __builtin_amdgcn_readlane(__builtin_bit_cast(int, x), srclane)); }
__device__ __forceinline__ int gla_rowbase(int b, int cidx) { return cidx < 4 ? NX + b * CTX + cidx * 64 : b * SEQ + (cidx - 4) * 64; }
__device__ __forceinline__ void gla_pass_a(const Args& a, const Frame& F) {
    const bf16* GK = (const bf16*)(a.ws + WS_GK); const bf16* GV = (const bf16*)(a.ws + WS_GV); const bf16* LA = (const bf16*)(a.ws + WS_LA);
    bf16* UC = (bf16*)(a.ws + WS_UC); float* DEC = (float*)(a.ws + WS_DEC);
    constexpr int TP = 144; typedef short v4i16_t __attribute__((ext_vector_type(4)));
    LAS unsigned char* Vt = F.lds; LAS unsigned char* KoT = F.lds + 256 * TP;
    const int lane = F.lane, w = F.wave, r32 = lane & 31, hh = lane >> 5;
    for (int item = F.vcu; item < 2176; item += F.G) {
        const int cidx = item % 68, dir = (item / 68) & 1, h = (item / 136) & 3, b = item / 544;
        const size_t row = (size_t)gla_rowbase(b, cidx) + lane;
        __syncthreads();
        {
            const int vt = F.tid >> 3, vc = F.tid & 7;
            const u32x4* src = (const u32x4*)(GV + ((size_t)gla_rowbase(b, cidx) + vt) * 1024 + h * 256 + 32 * vc);
#pragma unroll
            for (int q = 0; q < 4; ++q) *(LAS u32x4*)(Vt + vt * 576 + vc * 64 + 16 * q) = src[q];
        }
        {
            const bf16* lp = LA + ((size_t)dir * MT + row) * 512 + h * 128 + 16 * w;
            const u32x4* kp = (const u32x4*)(GK + row * 512 + h * 128 + 16 * w);
            const u32x4 k0 = kp[0], k1 = kp[1];
            const unsigned kw[8] = {k0.x, k0.y, k0.z, k0.w, k1.x, k1.y, k1.z, k1.w};
            const u32x4 l0 = *(const u32x4*)lp, l1 = *(const u32x4*)(lp + 8);
            float bc[16] = {bflo(l0.x), bfhi(l0.x), bflo(l0.y), bfhi(l0.y), bflo(l0.z), bfhi(l0.z), bflo(l0.w), bfhi(l0.w), bflo(l1.x), bfhi(l1.x), bflo(l1.y), bfhi(l1.y), bflo(l1.z), bfhi(l1.z), bflo(l1.w), bfhi(l1.w)};
            if (dir) scan_vec<16, true>(bc, lane); else scan_vec<16, false>(bc, lane);
#pragma unroll
            for (int j = 0; j < 16; ++j) {
                const float blast = dir ? lane_bcast(bc[j], 0) : lane_bcast(bc[j], 63);
                const float kv = (j & 1) ? bfhi(kw[j >> 1]) : bflo(kw[j >> 1]);
                *(LAS unsigned short*)(KoT + (16 * w + j) * TP + lane * 2) = (unsigned short)f2bf(kv * __expf(blast - bc[j]));
                if (lane == 0) DEC[(size_t)item * 128 + 16 * w + j] = __expf(blast); }
        }
        __syncthreads();
        f32x16 acc[4];
#pragma unroll
        for (int dt = 0; dt < 4; ++dt)
#pragma unroll
            for (int r = 0; r < 16; ++r) acc[dt][r] = 0.f;
#pragma unroll
        for (int ks = 0; ks < 4; ++ks) { const LAS unsigned char* vp = Vt + (16 * ks + 8 * hh + ((lane & 15) >> 2)) * 576 + (32 * w + 16 * ((lane >> 4) & 1) + 4 * (lane & 3)) * 2;
            const u32x2 alo = __builtin_bit_cast(u32x2, __builtin_amdgcn_ds_read_tr16_b64_v4i16((LAS v4i16_t*)vp)), ahi = __builtin_bit_cast(u32x2, __builtin_amdgcn_ds_read_tr16_b64_v4i16((LAS v4i16_t*)(vp + 4 * 576)));
            const bf16x8 af = __builtin_bit_cast(bf16x8, (u32x4){alo.x, alo.y, ahi.x, ahi.y});
#pragma unroll
            for (int dt = 0; dt < 4; ++dt) { const bf16x8 bf = *(const LAS bf16x8*)(KoT + (32 * dt + r32) * TP + (16 * ks + 8 * hh) * 2); acc[dt] = __builtin_amdgcn_mfma_f32_32x32x16_bf16(af, bf, acc[dt], 0, 0, 0); } }
        LAS unsigned char* ot = F.lds + 256 * TP + 128 * TP + w * (32 * 272);
#pragma unroll
        for (int dt = 0; dt < 4; ++dt)
#pragma unroll
            for (int r = 0; r < 16; ++r) *(LAS unsigned short*)(ot + ((r & 3) + 8 * (r >> 2) + 4 * hh) * 272 + (32 * dt + r32) * 2) = (unsigned short)f2bf(acc[dt][r]);
        bf16* out = UC + ((size_t)item * 256 + 32 * w) * 128;
#pragma unroll
        for (int i = 0; i < 8; ++i) { const int rr = (lane >> 4) + 4 * i, ch = lane & 15;
            *(u32x4*)(out + (size_t)rr * 128 + 8 * ch) = *(const LAS u32x4*)(ot + rr * 272 + ch * 16); }
    }
    __syncthreads();
}
__device__ __forceinline__ void gla_scan(const Args& a, const Frame& F) {
    bf16* UC = (bf16*)(a.ws + WS_UC); const float* DEC = (const float*)(a.ws + WS_DEC);
    for (int ch = F.gw * 64 + F.lane; ch < 32 * 256 * 16; ch += F.NGW * 64) {
        const int d8 = ch & 15, e = (ch >> 4) & 255, seq = ch >> 12, dir = seq & 1;
        float S[8];
#pragma unroll
        for (int j = 0; j < 8; ++j) S[j] = 0.f;
#pragma unroll 4
        for (int c = 0; c < 68; ++c) {
            const int cidx = dir == 0 ? c : (c < 4 ? 3 - c : 71 - c);
            const size_t item = (size_t)seq * 68 + cidx;
            u32x4* p = (u32x4*)(UC + (item * 256 + e) * 128 + 8 * d8);
            const f32x4 dc0 = *(const f32x4*)(DEC + item * 128 + 8 * d8), dc1 = *(const f32x4*)(DEC + item * 128 + 8 * d8 + 4);
            const u32x4 t = *p;
            u32x4 o; o.x = pg8::cvt_pk_bf16(S[0], S[1]); o.y = pg8::cvt_pk_bf16(S[2], S[3]); o.z = pg8::cvt_pk_bf16(S[4], S[5]); o.w = pg8::cvt_pk_bf16(S[6], S[7]);
            *p = o;
            S[0] = dc0.x * S[0] + bflo(t.x); S[1] = dc0.y * S[1] + bfhi(t.x); S[2] = dc0.z * S[2] + bflo(t.y); S[3] = dc0.w * S[3] + bfhi(t.y);
            S[4] = dc1.x * S[4] + bflo(t.z); S[5] = dc1.y * S[5] + bfhi(t.z); S[6] = dc1.z * S[6] + bflo(t.w); S[7] = dc1.w * S[7] + bfhi(t.w);
        }
    }
}
__device__ __forceinline__ void gla_pass_c(const Args& a, const Frame& F) {
    const bf16* GQ = (const bf16*)(a.ws + WS_GQ); const bf16* GK = (const bf16*)(a.ws + WS_GK); const bf16* GV = (const bf16*)(a.ws + WS_GV); const bf16* GR = (const bf16*)(a.ws + WS_GR);
    const bf16* LA = (const bf16*)(a.ws + WS_LA); const bf16* UC = (const bf16*)(a.ws + WS_UC); bf16* AB = (bf16*)(a.ws + WS_AB);
    constexpr int QP = 528, TP = 144, OP = 1040; typedef short v4i16_t __attribute__((ext_vector_type(4)));
    LAS unsigned char* Qc = F.lds; LAS unsigned char* Kc = F.lds + 64 * QP; LAS unsigned char* Pl = F.lds + 128 * QP; LAS unsigned char* Vt = Pl + 64 * TP; LAS unsigned char* Of = F.lds;
    const int lane = F.lane, w = F.wave, r32 = lane & 31, hh = lane >> 5, tid = F.tid;
    for (int item = F.vcu; item < 1088; item += F.G) {
        const int cidx = item % 68, h = (item / 68) & 3, b = item / 272;
        const int rowbase = gla_rowbase(b, cidx);
        const size_t row = (size_t)rowbase + lane;
        const size_t itf = ((size_t)(b * 4 + h) * 2) * 68 + cidx, itb = itf + 68;
        bf16x8 sb[16];
#pragma unroll
        for (int ks = 0; ks < 16; ++ks) sb[ks] = *(const bf16x8*)(UC + (((ks >> 3) ? itb : itf) * 256 + 32 * w + r32) * 128 + 16 * (ks & 7) + 8 * hh);
        u32x2 rwp[8];
        { const int t_ = tid >> 3, part_ = tid & 7;
#pragma unroll
            for (int i = 0; i < 8; ++i) rwp[i] = *(const u32x2*)(GR + ((size_t)rowbase + t_) * 1024 + h * 256 + 4 * part_ + 32 * i); }
        __syncthreads();
        {
            const int vt = tid >> 3, vc = tid & 7;
            const u32x4* src = (const u32x4*)(GV + ((size_t)rowbase + vt) * 1024 + h * 256 + 32 * vc);
#pragma unroll
            for (int q = 0; q < 4; ++q) *(LAS u32x4*)(Vt + vt * 576 + vc * 64 + 16 * q) = src[q];
        }
        {
            const bf16* lf = LA + row * 512 + h * 128 + 16 * w; const bf16* lb = lf + (size_t)MT * 512;
            const u32x4* qp = (const u32x4*)(GQ + row * 512 + h * 128 + 16 * w); const u32x4* kp = (const u32x4*)(GK + row * 512 + h * 128 + 16 * w);
            const u32x4 q0 = qp[0], q1 = qp[1], k0 = kp[0], k1 = kp[1];
            const unsigned qw[8] = {q0.x, q0.y, q0.z, q0.w, q1.x, q1.y, q1.z, q1.w}, kw[8] = {k0.x, k0.y, k0.z, k0.w, k1.x, k1.y, k1.z, k1.w};
            const u32x4 f0 = *(const u32x4*)lf, f1 = *(const u32x4*)(lf + 8), b0 = *(const u32x4*)lb, b1 = *(const u32x4*)(lb + 8);
            float bf[16] = {bflo(f0.x), bfhi(f0.x), bflo(f0.y), bfhi(f0.y), bflo(f0.z), bfhi(f0.z), bflo(f0.w), bfhi(f0.w), bflo(f1.x), bfhi(f1.x), bflo(f1.y), bfhi(f1.y), bflo(f1.z), bfhi(f1.z), bflo(f1.w), bfhi(f1.w)};
            float bb[16] = {bflo(b0.x), bfhi(b0.x), bflo(b0.y), bfhi(b0.y), bflo(b0.z), bfhi(b0.z), bflo(b0.w), bfhi(b0.w), bflo(b1.x), bfhi(b1.x), bflo(b1.y), bfhi(b1.y), bflo(b1.z), bfhi(b1.z), bflo(b1.w), bfhi(b1.w)};
            scan_vec<16, false>(bf, lane); scan_vec<16, true>(bb, lane);
            unsigned oqf[8], oqb[8], okf[8], okb[8];
#pragma unroll
            for (int p = 0; p < 8; ++p) {
                const float qa = bflo(qw[p]), qb2 = bfhi(qw[p]), ka = bflo(kw[p]), kb2 = bfhi(kw[p]);
                const float efa = __expf(bf[2 * p]), efb = __expf(bf[2 * p + 1]), eba = __expf(bb[2 * p]), ebb = __expf(bb[2 * p + 1]);
                oqf[p] = pk2(qa * efa, qb2 * efb); oqb[p] = pk2(qa * eba, qb2 * ebb);
                okf[p] = pk2(ka * __builtin_amdgcn_rcpf(efa), kb2 * __builtin_amdgcn_rcpf(efb)); okb[p] = pk2(ka * __builtin_amdgcn_rcpf(eba), kb2 * __builtin_amdgcn_rcpf(ebb));
            }
            LAS unsigned char* qd = Qc + lane * QP + 32 * w; LAS unsigned char* kd = Kc + lane * QP + 32 * w;
            *(LAS u32x4*)qd = (u32x4){oqf[0], oqf[1], oqf[2], oqf[3]}; *(LAS u32x4*)(qd + 16) = (u32x4){oqf[4], oqf[5], oqf[6], oqf[7]};
            *(LAS u32x4*)(qd + 256) = (u32x4){oqb[0], oqb[1], oqb[2], oqb[3]}; *(LAS u32x4*)(qd + 272) = (u32x4){oqb[4], oqb[5], oqb[6], oqb[7]};
            *(LAS u32x4*)kd = (u32x4){okf[0], okf[1], okf[2], okf[3]}; *(LAS u32x4*)(kd + 16) = (u32x4){okf[4], okf[5], okf[6], okf[7]};
            *(LAS u32x4*)(kd + 256) = (u32x4){okb[0], okb[1], okb[2], okb[3]}; *(LAS u32x4*)(kd + 272) = (u32x4){okb[4], okb[5], okb[6], okb[7]};
        }
        __syncthreads();
        if (w < 4) {
            const int ti = w >> 1, si = w & 1;
            f32x16 af, ab;
#pragma unroll
            for (int r = 0; r < 16; ++r) { af[r] = 0.f; ab[r] = 0.f; }
            if (si <= ti) {
#pragma unroll
                for (int ks = 0; ks < 8; ++ks) { const bf16x8 x = *(const LAS bf16x8*)(Qc + (32 * ti + r32) * QP + (16 * ks + 8 * hh) * 2), y = *(const LAS bf16x8*)(Kc + (32 * si + r32) * QP + (16 * ks + 8 * hh) * 2); af = __builtin_amdgcn_mfma_f32_32x32x16_bf16(x, y, af, 0, 0, 0); } }
            if (si >= ti) {
#pragma unroll
                for (int ks = 8; ks < 16; ++ks) { const bf16x8 x = *(const LAS bf16x8*)(Qc + (32 * ti + r32) * QP + (16 * ks + 8 * hh) * 2), y = *(const LAS bf16x8*)(Kc + (32 * si + r32) * QP + (16 * ks + 8 * hh) * 2); ab = __builtin_amdgcn_mfma_f32_32x32x16_bf16(x, y, ab, 0, 0, 0); } }
#pragma unroll
            for (int r = 0; r < 16; ++r) { const int t = 32 * ti + (r & 3) + 8 * (r >> 2) + 4 * hh, s = 32 * si + r32;
                const float v = (s <= t ? af[r] : 0.f) + (s >= t ? ab[r] : 0.f);
                *(LAS unsigned short*)(Pl + t * TP + s * 2) = (unsigned short)f2bf(v); }
        }
        __syncthreads();
        f32x16 o[2];
#pragma unroll
        for (int tt = 0; tt < 2; ++tt)
#pragma unroll
            for (int r = 0; r < 16; ++r) o[tt][r] = 0.f;
#pragma unroll
        for (int ks = 0; ks < 4; ++ks) { const LAS unsigned char* vp = Vt + (16 * ks + 8 * hh + ((lane & 15) >> 2)) * 576 + (32 * w + 16 * ((lane >> 4) & 1) + 4 * (lane & 3)) * 2;
            const u32x2 vlo = __builtin_bit_cast(u32x2, __builtin_amdgcn_ds_read_tr16_b64_v4i16((LAS v4i16_t*)vp)), vhi = __builtin_bit_cast(u32x2, __builtin_amdgcn_ds_read_tr16_b64_v4i16((LAS v4i16_t*)(vp + 4 * 576)));
            const bf16x8 vb = __builtin_bit_cast(bf16x8, (u32x4){vlo.x, vlo.y, vhi.x, vhi.y});
#pragma unroll
            for (int tt = 0; tt < 2; ++tt) { const bf16x8 pa = *(const LAS bf16x8*)(Pl + (32 * tt + r32) * TP + (16 * ks + 8 * hh) * 2); o[tt] = __builtin_amdgcn_mfma_f32_32x32x16_bf16(pa, vb, o[tt], 0, 0, 0); } }
#pragma unroll
        for (int kg = 0; kg < 4; ++kg) {
            bf16x8 qa[4][2];
#pragma unroll
            for (int k4 = 0; k4 < 4; ++k4)
#pragma unroll
                for (int tt = 0; tt < 2; ++tt) qa[k4][tt] = *(const LAS bf16x8*)(Qc + (32 * tt + r32) * QP + (16 * (4 * kg + k4) + 8 * hh) * 2);
            __builtin_amdgcn_sched_barrier(0);
#pragma unroll
            for (int k4 = 0; k4 < 4; ++k4)
#pragma unroll
                for (int tt = 0; tt < 2; ++tt) o[tt] = __builtin_amdgcn_mfma_f32_32x32x16_bf16(qa[k4][tt], sb[4 * kg + k4], o[tt], 0, 0, 0);
        }
        __syncthreads();
#pragma unroll
        for (int tt = 0; tt < 2; ++tt)
#pragma unroll
            for (int r = 0; r < 16; ++r) *(LAS float*)(Of + (32 * tt + (r & 3) + 8 * (r >> 2) + 4 * hh) * OP + (32 * w + r32) * 4) = o[tt][r];
        __syncthreads();
        {
            const int t = tid >> 3, part = tid & 7; const size_t orow = (size_t)rowbase + t;
            f32x4 v[8]; float ss = 0.f;
#pragma unroll
            for (int i = 0; i < 8; ++i) { v[i] = *(const LAS f32x4*)(Of + t * OP + (4 * part + 32 * i) * 4); ss += (v[i].x * v[i].x + v[i].y * v[i].y) + (v[i].z * v[i].z + v[i].w * v[i].w); }
            ss += __shfl_xor(ss, 1); ss += __shfl_xor(ss, 2); ss += __shfl_xor(ss, 4);
            const float rstd = rsqrtf(ss * (1.f / 256.f) + EPS);
#pragma unroll
            for (int i = 0; i < 8; ++i) { const int e = 4 * part + 32 * i;
                const f32x4 g = *(const f32x4*)(a.in[I_GNG] + h * 256 + e); const u32x2 rw = rwp[i];
                u32x2 ow; ow.x = pk2(v[i].x * rstd * g.x * silu_f(bflo(rw.x)), v[i].y * rstd * g.y * silu_f(bfhi(rw.x))); ow.y = pk2(v[i].z * rstd * g.z * silu_f(bflo(rw.y)), v[i].w * rstd * g.w * silu_f(bfhi(rw.y)));
                *(u32x2*)(AB + orow * 2048 + 1024 + h * 256 + e) = ow; }
        }
    }
    __syncthreads();
}

__device__ __forceinline__ void moe_route(const Args& a, const Frame& F, int nrows, unsigned* cnt) {
    const float* LOG = (const float*)(a.ws + WS_LOG); int* ROUTE = (int*)(a.ws + WS_ROUTE);
    for (int row = F.gw * 64 + F.lane; row < nrows; row += F.NGW * 64) {
        float lgv[36];
#pragma unroll
        for (int q = 0; q < 9; ++q) { f32x4 s = *(const f32x4*)(LOG + (size_t)row * 64 + 4 * q);
#pragma unroll
            for (int ksl = 1; ksl < 4; ++ksl) s += *(const f32x4*)(LOG + ((size_t)ksl * MT + row) * 64 + 4 * q);
            lgv[4 * q] = s.x; lgv[4 * q + 1] = s.y; lgv[4 * q + 2] = s.z; lgv[4 * q + 3] = s.w; }
        const f32x4 gl = {lgv[0], lgv[1], lgv[2], lgv[3]};
        int gi = 0; float gm = gl.x; if (gl.y > gm) { gm = gl.y; gi = 1; } if (gl.z > gm) { gm = gl.z; gi = 2; } if (gl.w > gm) { gm = gl.w; gi = 3; }
        const float ptop = 1.0f / (expf(gl.x - gm) + expf(gl.y - gm) + expf(gl.z - gm) + expf(gl.w - gm));
        float ev[8];
#pragma unroll
        for (int j = 0; j < 8; ++j) { const float c0 = gi & 1 ? lgv[12 + j] : lgv[4 + j], c1 = gi & 1 ? lgv[28 + j] : lgv[20 + j]; ev[j] = gi & 2 ? c1 : c0; }
        int i0 = 0; float v0 = ev[0];
#pragma unroll
        for (int j = 1; j < 8; ++j) if (ev[j] > v0) { v0 = ev[j]; i0 = j; }
        int i1 = -1; float v1 = -3.0e38f;
#pragma unroll
        for (int j = 0; j < 8; ++j) if (j != i0 && ev[j] > v1) { v1 = ev[j]; i1 = j; }
        const float t = expf(v1 - v0), w0 = ptop / (1.0f + t), w1 = ptop * t / (1.0f + t);
        const int x0 = gi * 8 + i0, x1 = gi * 8 + i1;
        const int s0 = (int)atomicAdd(cnt + x0, 1u), s1 = (int)atomicAdd(cnt + x1, 1u);
        int* r = ROUTE + (size_t)row * 8;
        r[0] = x0; r[1] = x1; r[2] = s0; r[3] = s1;
        int* LIST = (int*)(a.ws + WS_LIST); float* WLIST = (float*)(a.ws + WS_WLIST);
        LIST[(size_t)x0 * MT + s0] = row; LIST[(size_t)x1 * MT + s1] = row; WLIST[(size_t)x0 * MT + s0] = w0; WLIST[(size_t)x1 * MT + s1] = w1;
    }
}
__device__ __forceinline__ int moe_tables(const Frame& F, const unsigned* cnt) {
    LAS int* tab = (LAS int*)(F.lds + LDS_TAB);
    __syncthreads();
    if (F.tid < NE) tab[352 + F.tid] = (int)__hip_atomic_load(cnt + F.tid, __ATOMIC_RELAXED, __HIP_MEMORY_SCOPE_AGENT);
    __syncthreads();
    if (F.tid == 0) { int p = 0;
        for (int e = 0; e < NE; ++e) { const int c = tab[352 + e]; tab[384 + e] = p; const int nt = (c + 255) >> 8;
            for (int j = 0; j < nt; ++j) { tab[(p >> 8) + j] = e; tab[176 + (p >> 8) + j] = j; } p += nt << 8; }
        tab[384 + NE] = p; }
    __syncthreads();
    return tab[384 + NE] >> 8;
}
__device__ __forceinline__ void moe_combine_row(const Args& a, const LAS int* pstart, const LAS float* g2s, int row, int l, f32x4 (&v)[8], int lane) {
    const int* r = (const int*)(a.ws + WS_ROUTE) + (size_t)row * 8; const int d0 = pstart[r[0]] + r[2], d1 = pstart[r[1]] + r[3];
    const bf16* Y = (const bf16*)(a.ws + WS_Y); const bf16* XA = (const bf16*)(a.ws + WS_XA);
    int isctx, b, t; row_decode(row, isctx, b, t);
    const LAS float* g2 = g2s + (isctx ? 4 : b) * DM;
#pragma unroll
    for (int j = 0; j < 8; ++j) {
        const int c = 4 * lane + 256 * j;
        const u32x2 y0 = *(const u32x2*)(Y + (size_t)d0 * DM + c), y1 = *(const u32x2*)(Y + (size_t)d1 * DM + c);
        const u32x2 xw = *(const u32x2*)(XA + (size_t)row * DM + c); const f32x4 xv = {bflo(xw.x), bfhi(xw.x), bflo(xw.y), bfhi(xw.y)}, g = *(const LAS f32x4*)(g2 + c);
        f32x4 y; y.x = bflo(y0.x) + bflo(y1.x); y.y = bfhi(y0.x) + bfhi(y1.x); y.z = bflo(y0.y) + bflo(y1.y); y.w = bfhi(y0.y) + bfhi(y1.y);
        v[j] = xv + g * y;
    }
}

__device__ __forceinline__ void qk_norm(const Args& a, const Frame& F) {
    bf16* Q = (bf16*)(a.ws + WS_Q); bf16* K = (bf16*)(a.ws + WS_K);
    const float qsc = 0.08838834764831845f * 1.4426950408889634f;
    for (int item0 = F.gw; item0 < MT * 4; item0 += 4 * F.NGW) {
        u32x4 w[4]; bf16* base[4];
#pragma unroll
        for (int u = 0; u < 4; ++u) { const int item = min(item0 + u * F.NGW, MT * 4 - 1), row = item >> 2, part = 4 + (item & 3);
            base[u] = (part < 4 ? Q : K) + (size_t)row * DM + (part & 3) * 512 + 8 * F.lane; w[u] = *(const u32x4*)base[u]; }
#pragma unroll
        for (int u = 0; u < 4; ++u) {
            const int item = item0 + u * F.NGW; if (item >= MT * 4) break;
            const int part = 4 + (item & 3); const float* nw = (part < 4 ? a.in[I_QN] : a.in[I_KN]) + 8 * (F.lane & 15);
            float v[8] = {bflo(w[u].x), bfhi(w[u].x), bflo(w[u].y), bfhi(w[u].y), bflo(w[u].z), bfhi(w[u].z), bflo(w[u].w), bfhi(w[u].w)};
            float s = 0.f;
#pragma unroll
            for (int j = 0; j < 8; ++j) s += v[j] * v[j];
            s += __shfl_xor(s, 1); s += __shfl_xor(s, 2); s += __shfl_xor(s, 4); s += __shfl_xor(s, 8);
            const float rstd = rsqrtf(s * (1.f / 128.f) + EPS) * (part < 4 ? qsc : 1.0f);
            u32x4 o; o.x = pk2(v[0] * rstd * nw[0], v[1] * rstd * nw[1]); o.y = pk2(v[2] * rstd * nw[2], v[3] * rstd * nw[3]); o.z = pk2(v[4] * rstd * nw[4], v[5] * rstd * nw[5]); o.w = pk2(v[6] * rstd * nw[6], v[7] * rstd * nw[7]);
            *(u32x4*)base[u] = o;
        }
    }
}

__device__ __forceinline__ void na_naive(const Args& a, const Frame& F) {
    const bf16* Q = (const bf16*)(a.ws + WS_Q); const bf16* K = (const bf16*)(a.ws + WS_K); const bf16* V = (const bf16*)(a.ws + WS_V); bf16* O = (bf16*)(a.ws + WS_O);
    LAS float* qs = (LAS float*)(F.lds + F.wave * 4096);
    LAS float* ps = qs + 128;
    const float* RPB = a.in[I_RPB];
    const int lane = F.lane;
    for (int item = F.gw; item < NX * NAH; item += F.NGW) {
        const int tok = item >> 4, h = item & 15, b = tok >> 12, t = tok & 4095, r = t >> 6, qc = t & 63;
        const int start = min(max(r - 4, 0), 56), cs = min(max(qc - 8, 0), 48);
        { const unsigned w = *(const unsigned*)(Q + (size_t)tok * DM + h * 128 + 2 * lane); qs[2 * lane] = bflo(w); qs[2 * lane + 1] = bfhi(w); }
        LDS_WAIT();
        float s[6]; float mx = -3.0e38f;
#pragma unroll
        for (int i = 0; i < 6; ++i) {
            const int j = lane + 64 * i; size_t krow; float bias = 0.f;
            if (j < 128) { const int kr = j >> 4, kc = cs + (j & 15); krow = (size_t)b * SEQ + (start + kr) * 64 + kc; bias = RPB[((size_t)h * 15 + (start + kr - r + 7)) * 31 + (kc - qc + 15)] * 1.4426950408889634f; }
            else krow = (size_t)NX + b * CTX + (j - 128);
            const u32x4* kp = (const u32x4*)(K + krow * DM + h * 128);
            float dot = 0.f;
#pragma unroll
            for (int c = 0; c < 16; ++c) { const u32x4 kw = kp[c]; const f32x4 qa = *(const LAS f32x4*)(qs + 8 * c), qb = *(const LAS f32x4*)(qs + 8 * c + 4);
                dot += bflo(kw.x) * qa.x + bfhi(kw.x) * qa.y + bflo(kw.y) * qa.z + bfhi(kw.y) * qa.w + bflo(kw.z) * qb.x + bfhi(kw.z) * qb.y + bflo(kw.w) * qb.z + bfhi(kw.w) * qb.w; }
            s[i] = dot + bias; mx = fmaxf(mx, s[i]);
        }
        mx = wave_max(mx);
        float l = 0.f;
#pragma unroll
        for (int i = 0; i < 6; ++i) { const float p = exp2f(s[i] - mx); l += p; ps[lane + 64 * i] = p; }
        l = wave_sum(l);
        LDS_WAIT();
        float o0 = 0.f, o1 = 0.f;
        for (int j = 0; j < 384; ++j) {
            size_t vrow;
            if (j < 128) vrow = (size_t)b * SEQ + (start + (j >> 4)) * 64 + cs + (j & 15); else vrow = (size_t)NX + b * CTX + (j - 128);
            const unsigned w = *(const unsigned*)(V + vrow * DM + h * 128 + 2 * lane); const float p = ps[j];
            o0 += p * bflo(w); o1 += p * bfhi(w);
        }
        const float il = 1.0f / l;
        *(unsigned*)(O + (size_t)tok * DM + h * 128 + 2 * lane) = pk2(o0 * il, o1 * il);
    }
}


#ifndef K_NORM_IN_NA
#define K_NORM_IN_NA 1
#endif
template <bool DYN>
__device__ __forceinline__ void na_fast(const Args& a, const Frame& F, unsigned* qctr, int qbase, int qend) {
    const bf16* Q = (const bf16*)(a.ws + WS_Q); const bf16* K = (const bf16*)(a.ws + WS_K); const bf16* V = (const bf16*)(a.ws + WS_V); bf16* O = (bf16*)(a.ws + WS_O);
    constexpr int KP = 272, VP = 320, BUFB = 64 * KP + 64 * VP;
    typedef short v4i16_t __attribute__((ext_vector_type(4)));
    LAS unsigned char* rp2 = F.lds + 2 * BUFB;
    LAS float* gq = (LAS float*)(rp2 + 2048);
    const float* RPB = a.in[I_RPB];
    const int lane = F.lane, r32 = lane & 31, hh = lane >> 5, w = F.wave, tid = F.tid;
    const int skey = tid >> 3, sch = tid & 7;
    volatile LAS int* slot = (volatile LAS int*)(F.lds + LDS_MISC) + 16;
    int item = F.vcu; const int iend = DYN ? qend : NB * NAH * 16;
    if (DYN) { __syncthreads(); if (tid == 0) slot[0] = qbase + (int)atomicAdd(qctr, 1u); __syncthreads(); item = __builtin_amdgcn_readfirstlane(slot[0]); }
    while (item < iend) {
        const int rg = item & 15, h = (item >> 4) & 15, b = item >> 8;
        const int qr = rg * 4 + (w >> 1), qc = 32 * (w & 1) + r32;
        const size_t tok = (size_t)b * SEQ + qr * 64 + qc;
        const int start = min(max(qr - 4, 0), 56), cs = min(max(qc - 8, 0), 48);
        const int kr_lo = min(max(rg * 4 - 4, 0), 56), kr_hi = min(max(rg * 4 - 1, 0), 56) + 7, nblk = 4 + (kr_hi - kr_lo + 1);
        bf16x8 qf[8];
#pragma unroll
        for (int ks = 0; ks < 8; ++ks) qf[ks] = *(const bf16x8*)(Q + tok * DM + h * 128 + 16 * ks + 8 * hh);
        unsigned boffp[8];
#pragma unroll
        for (int wd = 0; wd < 8; ++wd) { unsigned pk = 0;
#pragma unroll
            for (int j = 0; j < 4; ++j) { const int kt = wd >> 2, r = 4 * (wd & 3) + j, kc = 32 * kt + (r & 3) + 8 * (r >> 2) + 4 * hh; pk |= (unsigned)(((unsigned)(kc - cs) < 16u) ? (kc - qc + 15) * 4 : 31 * 4) << (8 * j); }
            boffp[wd] = pk; }
        u32x4 kg0, kg1, vg0, vg1;
#define NA_LOAD(nb_) do { const int nb__ = (nb_); const size_t rowbase = nb__ < 4 ? (size_t)NX + b * CTX + nb__ * 64 : (size_t)b * SEQ + (kr_lo + nb__ - 4) * 64; \
            const u32x4* ksrc = (const u32x4*)(K + (rowbase + skey) * DM + h * 128 + 16 * sch); kg0 = ksrc[0]; kg1 = ksrc[1]; \
            const u32x4* vsrc = (const u32x4*)(V + (rowbase + skey) * DM + h * 128 + 16 * sch); vg0 = vsrc[0]; vg1 = vsrc[1]; } while (0)
#define NA_KSQ(w_) ((bflo(w_.x) * bflo(w_.x) + bfhi(w_.x) * bfhi(w_.x)) + (bflo(w_.y) * bflo(w_.y) + bfhi(w_.y) * bfhi(w_.y)) + (bflo(w_.z) * bflo(w_.z) + bfhi(w_.z) * bfhi(w_.z)) + (bflo(w_.w) * bflo(w_.w) + bfhi(w_.w) * bfhi(w_.w)))
#define NA_KSC(w_, r_) do { w_.x = pg8::cvt_pk_bf16(bflo(w_.x) * r_, bfhi(w_.x) * r_); w_.y = pg8::cvt_pk_bf16(bflo(w_.y) * r_, bfhi(w_.y) * r_); w_.z = pg8::cvt_pk_bf16(bflo(w_.z) * r_, bfhi(w_.z) * r_); w_.w = pg8::cvt_pk_bf16(bflo(w_.w) * r_, bfhi(w_.w) * r_); } while (0)
#define NA_STAGE(buf_) do { LAS unsigned char* Ks_ = F.lds + (buf_) * BUFB; LAS unsigned char* Vt_ = Ks_ + 64 * KP; \
            if (K_NORM_IN_NA) { float ss_ = NA_KSQ(kg0) + NA_KSQ(kg1);       \
                ss_ += dpp_mov0<0xB1, 0xF, true>(ss_); ss_ += dpp_mov0<0x4E, 0xF, true>(ss_); ss_ += dpp_mov0<0x141, 0xF, true>(ss_); \
                const float rk_ = rsqrtf(ss_ * (1.f / 128.f) + EPS); NA_KSC(kg0, rk_); NA_KSC(kg1, rk_); } \
            *(LAS u32x4*)(Ks_ + skey * KP + sch * 32) = kg0; *(LAS u32x4*)(Ks_ + skey * KP + sch * 32 + 16) = kg1; \
            *(LAS u32x4*)(Vt_ + skey * VP + sch * 32) = vg0; *(LAS u32x4*)(Vt_ + skey * VP + sch * 32 + 16) = vg1; } while (0)
        int nxt = 0;
        if (DYN && tid == 0) nxt = qbase + (int)atomicAdd(qctr, 1u);
        NA_LOAD(0);
        __syncthreads();
        for (int i = tid; i < 15 * 32; i += 512) { const int dr = i >> 5, c = i & 31; *(LAS float*)(rp2 + i * 4) = c < 31 ? RPB[h * 465 + dr * 31 + c] * 1.4426950408889634f : -1.0e30f; }
        if (tid < 128) gq[tid] = a.in[I_QN][tid] * (K_NORM_IN_NA ? a.in[I_KN][tid] : 1.0f);
        NA_STAGE(0);
        if (DYN && tid == 0) slot[0] = nxt;
        NA_LOAD(1);
        __syncthreads();
        {
            float ss = 0.f;
#pragma unroll
            for (int ks = 0; ks < 8; ++ks) { const u32x4 qw = __builtin_bit_cast(u32x4, qf[ks]);
                ss += (bflo(qw.x) * bflo(qw.x) + bfhi(qw.x) * bfhi(qw.x)) + (bflo(qw.y) * bflo(qw.y) + bfhi(qw.y) * bfhi(qw.y)) + (bflo(qw.z) * bflo(qw.z) + bfhi(qw.z) * bfhi(qw.z)) + (bflo(qw.w) * bflo(qw.w) + bfhi(qw.w) * bfhi(qw.w)); }
            ss += __shfl_xor(ss, 32);
            const float rstd = rsqrtf(ss * (1.f / 128.f) + EPS) * (0.08838834764831845f * 1.4426950408889634f);
#pragma unroll
            for (int ks = 0; ks < 8; ++ks) { const u32x4 qw = __builtin_bit_cast(u32x4, qf[ks]);
                const f32x4 n0 = *(const LAS f32x4*)(gq + 16 * ks + 8 * hh), n1 = *(const LAS f32x4*)(gq + 16 * ks + 8 * hh + 4);
                u32x4 o; o.x = pk2(bflo(qw.x) * rstd * n0.x, bfhi(qw.x) * rstd * n0.y); o.y = pk2(bflo(qw.y) * rstd * n0.z, bfhi(qw.y) * rstd * n0.w);
                o.z = pk2(bflo(qw.z) * rstd * n1.x, bfhi(qw.z) * rstd * n1.y); o.w = pk2(bflo(qw.w) * rstd * n1.z, bfhi(qw.w) * rstd * n1.w);
                qf[ks] = __builtin_bit_cast(bf16x8, o); }
        }
        f32x16 ot[4];
#pragma unroll
        for (int dt = 0; dt < 4; ++dt)
#pragma unroll
            for (int r = 0; r < 16; ++r) ot[dt][r] = 0.f;
        float m = 0.f, l = 0.f;
#define NA_BODY(BUF) do { \
            const int krow = blk < 4 ? -1 : kr_lo + blk - 4; \
            const LAS unsigned char* Ks = F.lds + (BUF) * BUFB; const LAS unsigned char* Vt = Ks + 64 * KP; \
            const bool mine = blk < 4 || (krow >= start && krow < start + 8); \
            if (blk + 1 < nblk) NA_STAGE(1 - (BUF)); \
            if (blk + 2 < nblk) NA_LOAD(blk + 2); \
            if (mine) { \
                const LAS unsigned char* brow = rp2 + (krow - qr + 7) * 128; \
_Pragma("unroll") \
                for (int kt = 0; kt < 2; ++kt) { \
                    f32x16 st; bf16x8 kfr[8]; \
                    if (blk >= 4) { _Pragma("unroll") for (int r = 0; r < 16; ++r) st[r] = *(const LAS float*)(brow + ((boffp[kt * 4 + (r >> 2)] >> (8 * (r & 3))) & 0xffu)) - m; } \
                    else { _Pragma("unroll") for (int r = 0; r < 16; ++r) st[r] = -m; } \
_Pragma("unroll") \
                    for (int ks = 0; ks < 8; ++ks) kfr[ks] = *(const LAS bf16x8*)(Ks + (32 * kt + r32) * KP + (16 * ks + 8 * hh) * 2); \
                    __builtin_amdgcn_sched_barrier(0); \
                    __builtin_amdgcn_s_setprio(1); \
_Pragma("unroll") \
                    for (int ks = 0; ks < 8; ++ks) st = __builtin_amdgcn_mfma_f32_32x32x16_bf16(kfr[ks], qf[ks], st, 0, 0, 0); \
                    __builtin_amdgcn_s_setprio(0); \
                    float tmax = -3.0e38f; \
_Pragma("unroll") \
                    for (int r = 0; r < 16; ++r) tmax = fmaxf(tmax, st[r]); \
                    tmax = fmaxf(tmax, __shfl_xor(tmax, 32)); \
                    float alpha = 1.0f; \
                    const bool first = (blk == 0) && (kt == 0);        \
                    const bool resc = first || !__all(tmax <= 8.0f); \
                    if (resc) { const float dm = first ? tmax : fmaxf(tmax, 0.f); alpha = first ? 1.0f : __builtin_amdgcn_exp2f(-dm); m += dm; \
_Pragma("unroll") \
                        for (int r = 0; r < 16; ++r) st[r] -= dm; } \
                    float psum = 0.f; unsigned pw[8]; \
_Pragma("unroll") \
                    for (int r = 0; r < 16; r += 2) { const float p0 = __builtin_amdgcn_exp2f(st[r]), p1 = __builtin_amdgcn_exp2f(st[r + 1]); psum += p0 + p1; pw[r >> 1] = pg8::cvt_pk_bf16(p0, p1); } \
                    l = l * alpha + psum; \
                    if (resc) { \
_Pragma("unroll") \
                        for (int dt = 0; dt < 4; ++dt) \
_Pragma("unroll") \
                            for (int r = 0; r < 16; ++r) ot[dt][r] *= alpha; \
                    } \
_Pragma("unroll") \
                    for (int s2 = 0; s2 < 2; ++s2) { \
                        const u32x4 pbw = {pw[4 * s2], pw[4 * s2 + 1], pw[4 * s2 + 2], pw[4 * s2 + 3]}; \
                        const bf16x8 pb = __builtin_bit_cast(bf16x8, pbw); \
_Pragma("unroll") \
                        for (int dt = 0; dt < 4; ++dt) { \
                            const LAS unsigned char* vp = Vt + (32 * kt + 16 * s2 + 4 * hh + ((lane & 15) >> 2)) * VP + (32 * dt + 16 * ((lane >> 4) & 1) + 4 * (lane & 3)) * 2; \
                            const u32x2 lo = __builtin_bit_cast(u32x2, __builtin_amdgcn_ds_read_tr16_b64_v4i16((LAS v4i16_t*)vp)), hi = __builtin_bit_cast(u32x2, __builtin_amdgcn_ds_read_tr16_b64_v4i16((LAS v4i16_t*)(vp + 8 * VP))); \
                            const u32x4 vw = {lo.x, lo.y, hi.x, hi.y}; \
                            ot[dt] = __builtin_amdgcn_mfma_f32_32x32x16_bf16(__builtin_bit_cast(bf16x8, vw), pb, ot[dt], 0, 0, 0); \
                        } \
                    } \
                } \
            } \
            __syncthreads(); \
        } while (0)
        for (int blk = 0; blk < nblk; ) { NA_BODY(0); if (++blk >= nblk) break; NA_BODY(1); ++blk; }
#undef NA_BODY
#undef NA_LOAD
#undef NA_STAGE
#undef NA_KSQ
#undef NA_KSC
        const float il = 1.0f / (l + __shfl_xor(l, 32));
#pragma unroll
        for (int dt = 0; dt < 4; ++dt)
#pragma unroll
            for (int g4 = 0; g4 < 4; ++g4) {
                u32x2 o; o.x = pg8::cvt_pk_bf16(ot[dt][4 * g4] * il, ot[dt][4 * g4 + 1] * il); o.y = pg8::cvt_pk_bf16(ot[dt][4 * g4 + 2] * il, ot[dt][4 * g4 + 3] * il);
                *(u32x2*)(O + tok * DM + h * 128 + 32 * dt + 8 * g4 + 4 * hh) = o;
            }
        if (DYN) item = __builtin_amdgcn_readfirstlane(slot[0]); else item += F.G;
    }
    __syncthreads();
}

#ifndef S5_NAIVE
#define S5_NAIVE 0
#endif
#ifndef GLA_NAIVE
#define GLA_NAIVE 0
#endif
#ifndef NA_NAIVE
#define NA_NAIVE 0
#endif
#ifndef NA_CONV_OVERLAP
#define NA_CONV_OVERLAP 1
#endif
#ifndef K_NORM_IN_NA
#define K_NORM_IN_NA 1
#endif
#ifndef NA_CONV_FIRST_E
#define NA_CONV_FIRST_E 3
#endif
#ifndef PROBE_REPEAT_MASK
#define PROBE_REPEAT_MASK 0u
#endif
#ifndef PROBE_EPI2
#define PROBE_EPI2 0
#endif
#ifndef PROBE_SUB
#define PROBE_SUB 0
#endif
#define SUBREP(id) _Pragma("nounroll") for (int srep_ = 0; srep_ < ((PROBE_SUB) == (id) ? 3 : 1); ++srep_)
#ifndef MK_PER_PHASE
#define MK_PER_PHASE 0
#endif
enum { PH_PRO = 0, PH_MOD1, PH_INPROJ, PH_PREP, PH_MIXA, PH_MIXB, PH_MIXC, PH_OUT, PH_MOD2_L0, PH_ROUTER_L0, PH_ROUTE_L0, PH_GU_L0, PH_DOWN_L0, PH_COMB_L0,
       PH_QKV, PH_QKNORM, PH_NA, PH_NAO, PH_MOD2_L1, PH_ROUTER_L1, PH_ROUTE_L1, PH_GU_L1, PH_DOWN_L1, PH_COMB_L1, NPH };

__global__ void __launch_bounds__(512, 2) fwd_kernel(Args args) {
    extern __shared__ __attribute__((aligned(16))) unsigned char lds_raw[];
    Frame F;
    F.lds = (LAS unsigned char*)lds_raw;
    F.tid = threadIdx.x; F.lane = F.tid & 63; F.wave = __builtin_amdgcn_readfirstlane(F.tid >> 6);
    F.G = gridDim.x; { const int bx = blockIdx.x; F.vcu = (F.G % 8 == 0) ? (bx % 8) * (F.G / 8) + bx / 8 : bx; }
    F.gw = F.vcu * 8 + F.wave; F.NGW = F.G * 8;
    volatile LAS unsigned* MISC = (volatile LAS unsigned*)(F.lds + LDS_MISC);
    unsigned char* ws = args.ws;
    gu32* ctl = (gu32*)(ws + WS_CTL);
    for (int u = F.tid; u < (LDS_BYTES - LDS_MISC) / 4; u += 512) ((LAS unsigned*)(F.lds + LDS_MISC))[u] = 0u;
    __syncthreads();
    XcdBarrier bar; bar.bar = (unsigned*)ctl + CW_BAR; bar.x = 0; bar.st = nullptr;
    if (args.use_bar) bar = xcd_barrier_post((unsigned*)ctl + CW_BAR, MISC + 8);
    const int lo = args.ph_lo, hi = args.ph_hi;
#define IN(k) (lo <= (k) && (k) < hi)
#define REPS(k) _Pragma("unroll") for (int rep_ = 0; rep_ < (int)(((PROBE_REPEAT_MASK) >> (k)) & 1u) + 1; ++rep_)
#define SEAM(k) do { if (IN(k) && IN((k) + 1)) xcd_barrier(bar); } while (0)
    LAS unsigned char* ring = F.lds;
    float* MOD = (float*)(ws + WS_MOD);
    bf16* H = (bf16*)(ws + WS_H); bf16* XA = (bf16*)(ws + WS_XA);
    const int bid = (int)blockIdx.x;
    const int rpb = (MT + F.G - 1) / F.G, rb0 = F.vcu * rpb, rb1 = min(MT, rb0 + rpb);

    if (IN(PH_PRO)) REPS(PH_PRO) { p0_prologue(args, F); }
    SEAM(PH_PRO);
    if (IN(PH_MOD1)) REPS(PH_MOD1) {
        LAS float* mods = (LAS float*)F.lds;
        __syncthreads(); stage_mod_lds(mods, args.in[I_N1G], MOD, 0, DM, F.tid); __syncthreads();
        for (int row = rb0 + F.wave; row < rb1; row += 16) {
            const int row2 = row + 8; const bool has2 = row2 < rb1;
            int isctx, b, t, isctx2, b2, t2; row_decode(row, isctx, b, t); row_decode(has2 ? row2 : row, isctx2, b2, t2);
            const float* xin = isctx ? args.in[I_CTX] + (size_t)(row - NX) * DM : args.in[I_X] + (size_t)row * DM;
            const float* xin2 = isctx2 ? args.in[I_CTX] + (size_t)((has2 ? row2 : row) - NX) * DM : args.in[I_X] + (size_t)(has2 ? row2 : row) * DM;
            const float* mr = MOD + (size_t)(isctx ? 4 : b) * MODW; const float* mr2 = MOD + (size_t)(isctx2 ? 4 : b2) * MODW;
            f32x4 v[8], v2[8]; load_row(xin, v, F.lane); load_row(xin2, v2, F.lane);
            const int mi = isctx ? 4 : b, mi2 = isctx2 ? 4 : b2;
            modulate_store_lds(v, mods, mods + DM + 2 * mi * DM, mods + DM + (2 * mi + 1) * DM, H + (size_t)row * DM, F.lane);
            if (has2) modulate_store_lds(v2, mods, mods + DM + 2 * mi2 * DM, mods + DM + (2 * mi2 + 1) * DM, H + (size_t)row2 * DM, F.lane);
        }
    }
    SEAM(PH_MOD1);
    if (IN(PH_INPROJ)) REPS(PH_INPROJ) {
        pg8::Gemm g{DM, DM, DM}; pg8::DenseOrder S{(const char*)H, (const char*)(ws + WS_WIN), DM, DM, MT / 256, AB_IN_PAD / 256, F.G, bid, 0};
        EpiInProj<S5_NAIVE != 0> E{(bf16*)(ws + WS_UEXT), (bf16*)(ws + WS_GQ), (bf16*)(ws + WS_GK), (bf16*)(ws + WS_GV), (bf16*)(ws + WS_GR), (float*)(ws + WS_LOWR)};
        pg8::gemm_phase<decltype(E), pg8::DenseOrder, true, true>(ring, g, S, E);
    }
    SEAM(PH_INPROJ);
    if (IN(PH_PREP)) {
        gla_prep(args, F);
#if !S5_NAIVE
        {
            pg8::Gemm g{512, 256, 256}; pg8::S5Order S{(const char*)(ws + WS_UEXT), (const char*)(ws + WS_SE), 512, 256, F.G, bid, (size_t)S5COLS_PAD * 512 * 2, (size_t)256 * 256 * 2};
            EpiS5E E{(bf16*)(ws + WS_LST)};
            SUBREP(3) pg8::gemm_phase<EpiS5E, pg8::S5Order, true, true>(ring, g, S, E);
        }
#endif
    }
    SEAM(PH_PREP);
    if (IN(PH_MIXA)) REPS(PH_MIXA) {
#if GLA_NAIVE
        gla_naive(args, F);
#else
        SUBREP(1) gla_pass_a(args, F);
#endif
#if S5_NAIVE
        s5_naive(args, F);
#else
        SUBREP(2) s5_scan(args, F);
#endif
#if CONV0_MIXA
        moe_convert_dyn(args, F, 0, (unsigned*)ctl + CW_QC0 + 96, CONV0_LATE, CONV0_MIXA);
#endif
    }
    SEAM(PH_MIXA);
    if (IN(PH_MIXB)) {
#if S5_NAIVE
        s5_finish_naive(args, F);
#else
        {
            pg8::Gemm g{512, 512, 512}; pg8::S5Order S{(const char*)(ws + WS_UEXT), (const char*)(ws + WS_SM), 512, 512, F.G, bid, (size_t)S5COLS_PAD * 512 * 2, (size_t)256 * 512 * 2};
            EpiS5C E{(bf16*)(ws + WS_G)};
            SUBREP(4) pg8::gemm_phase<EpiS5C, pg8::S5Order, true, true>(ring, g, S, E);
        }
#endif
#if GLA_NAIVE
        gla_finish_naive(args, F);
#else
        gla_scan(args, F);
#endif
    }
    SEAM(PH_MIXB);
    if (IN(PH_MIXC)) REPS(PH_MIXC) {
        {
        pg8::Gemm g{1024, 1024, 1024}; pg8::DenseOrder S{(const char*)(ws + WS_G), (const char*)(ws + WS_WGLU), 1024, 1024, MT / 256, 4, F.G, bid, 1};
        EpiGlu E{(const bf16*)(ws + WS_G), (bf16*)(ws + WS_AB)};
        pg8::gemm_phase<EpiGlu, pg8::DenseOrder, true, true, false, true>(ring, g, S, E);
            }
#if !GLA_NAIVE
#if CONV0_LATE
        {
            const bool convFirst = ((bid >> 3) & 1) != 0;
#pragma nounroll
            for (int pass = 0; pass < 4; ++pass) {
                if (pass == 1) { gla_pass_c(args, F); continue; }
                if (pass == 0 && !convFirst) continue;
                moe_convert_dyn(args, F, 0, (unsigned*)ctl + CW_QC0 + (pass == 3 ? 32 : 0), pass == 3 ? CONV0_Q1 : 0, pass == 3 ? CONV0_Q2 : CONV0_Q1);
            }
        }
#else
        SUBREP(5) gla_pass_c(args, F);
#endif
#endif
    }
    SEAM(PH_MIXC);
    if (IN(PH_OUT)) REPS(PH_OUT) {
        pg8::Gemm g{DM, DM, DM}; pg8::DenseOrder S{(const char*)(ws + WS_AB), (const char*)(ws + WS_WOUT), DM, DM, MT / 256, 8, F.G, bid, 1};
        EpiRes<true> E{args.in[I_X], args.in[I_CTX], XA, MOD + 2 * DM};
        pg8::gemm_phase<EpiRes<true>, pg8::DenseOrder, true, true, false, true>(ring, g, S, E);
    }
    SEAM(PH_OUT);
    if (IN(PH_MOD2_L0)) REPS(PH_MOD2_L0) {
        LAS float* mods = (LAS float*)F.lds;
        __syncthreads(); stage_mod_lds(mods, args.in[I_N2G], MOD, 3 * DM, 4 * DM, F.tid); __syncthreads();
        for (int row = rb0 + F.wave; row < rb1; row += 16) {
            const int row2 = row + 8; const bool has2 = row2 < rb1; const int rr2 = has2 ? row2 : row;
            int isctx, b, t, isctx2, b2, t2; row_decode(row, isctx, b, t); row_decode(rr2, isctx2, b2, t2);
            const float* mr = MOD + (size_t)(isctx ? 4 : b) * MODW; const float* mr2 = MOD + (size_t)(isctx2 ? 4 : b2) * MODW;
            f32x4 v[8], v2[8]; load_row_bf16(XA + (size_t)row * DM, v, F.lane); load_row_bf16(XA + (size_t)rr2 * DM, v2, F.lane);
            const int mi = isctx ? 4 : b, mi2 = isctx2 ? 4 : b2;
            modulate_store_lds(v, mods, mods + DM + 2 * mi * DM, mods + DM + (2 * mi + 1) * DM, H + (size_t)row * DM, F.lane);
            if (has2) modulate_store_lds(v2, mods, mods + DM + 2 * mi2 * DM, mods + DM + (2 * mi2 + 1) * DM, H + (size_t)row2 * DM, F.lane);
        }
    }
    SEAM(PH_MOD2_L0);
#define MOE_PHASES(L, NROWS, CNTW, P_ROUTER, P_ROUTE, P_GU, P_DOWN) \
    if (IN(P_ROUTER)) REPS(P_ROUTER) { \
        pg8::Gemm g{DM, DM, 512}; pg8::RouterOrder S{(const char*)H, (const char*)(ws + WS_WR + (size_t)(L) * 256 * DM * 2), (NROWS) / 256, F.G, bid}; \
        EpiRouter E{(float*)(ws + WS_LOG)}; \
        pg8::gemm_phase<EpiRouter, pg8::RouterOrder, true, true>(ring, g, S, E); \
    } \
    SEAM(P_ROUTER); \
    if (IN(P_ROUTE)) { moe_route(args, F, (NROWS), (unsigned*)ctl + (CNTW)); } \
    SEAM(P_ROUTE); \
    if (IN(P_GU)) REPS(P_GU) { \
        const int ntile = moe_tables(F, (const unsigned*)ctl + (CNTW)); \
        pg8::Gemm g{DM, DM, DM}; pg8::GroupOrder S{(const char*)H, (const char*)(ws + WS_WGU), DM, DM, ntile, 8, F.G, bid, (size_t)2048 * 2048 * 2, (const LAS int*)(F.lds + LDS_TAB), (const int*)(ws + WS_LIST)}; \
        EpiGU E{(bf16*)(ws + WS_HH)}; \
        pg8::gemm_phase<EpiGU, pg8::GroupOrder, true, true, true>(ring, g, S, E); \
    } \
    SEAM(P_GU); \
    if (IN(P_DOWN)) REPS(P_DOWN) { \
        const int ntile = moe_tables(F, (const unsigned*)ctl + (CNTW)); \
        pg8::Gemm g{MOEF, MOEF, MOEF}; pg8::GroupOrder S{(const char*)(ws + WS_HH), (const char*)(ws + WS_WD), MOEF, MOEF, ntile, 8, F.G, bid, (size_t)2048 * 1024 * 2, (const LAS int*)(F.lds + LDS_TAB), nullptr}; \
        EpiDown E{(bf16*)(ws + WS_Y), (const float*)(ws + WS_WLIST), (const LAS int*)(F.lds + LDS_TAB)}; \
        pg8::gemm_phase<EpiDown, pg8::GroupOrder, true, true>(ring, g, S, E); \
    } \
    SEAM(P_DOWN);
    MOE_PHASES(0, MT, CW_CNT0, PH_ROUTER_L0, PH_ROUTE_L0, PH_GU_L0, PH_DOWN_L0)
    if (IN(PH_COMB_L0)) {
        (void)moe_tables(F, (const unsigned*)ctl + CW_CNT0);
        LAS float* mods = (LAS float*)F.lds;
        stage_mod_lds(mods, args.in[I_N1G] + DM, MOD + (size_t)5 * MODW, 0, DM, F.tid);
        LAS float* g2s = mods + 11 * DM;
        for (int i = F.tid; i < 5 * DM / 4; i += 512) { const int r = i / (DM / 4), c = (i % (DM / 4)) * 4; *(LAS f32x4*)(g2s + r * DM + c) = *(const f32x4*)(MOD + (size_t)r * MODW + 5 * DM + c); }
        __syncthreads();
        for (int row = rb0 + F.wave; row < rb1; row += 16) {
            const int row2 = row + 8; const bool has2 = row2 < rb1; const int rr2 = has2 ? row2 : row;
            int isctx, b, t, isctx2, b2, t2; row_decode(row, isctx, b, t); row_decode(rr2, isctx2, b2, t2);
            f32x4 v[8], v2[8]; moe_combine_row(args, (const LAS int*)(F.lds + LDS_TAB) + 384, g2s, row, 0, v, F.lane); moe_combine_row(args, (const LAS int*)(F.lds + LDS_TAB) + 384, g2s, rr2, 0, v2, F.lane);
            store_row_bf16(XA + (size_t)row * DM, v, F.lane);
            const float* mr = MOD + (size_t)(5 + (isctx ? 4 : b)) * MODW; const float* mr2 = MOD + (size_t)(5 + (isctx2 ? 4 : b2)) * MODW;
            const int mi = isctx ? 4 : b, mi2 = isctx2 ? 4 : b2;
            modulate_store_lds(v, mods, mods + DM + 2 * mi * DM, mods + DM + (2 * mi + 1) * DM, H + (size_t)row * DM, F.lane);
            if (has2) {
                store_row_bf16(XA + (size_t)row2 * DM, v2, F.lane);
                modulate_store_lds(v2, mods, mods + DM + 2 * mi2 * DM, mods + DM + (2 * mi2 + 1) * DM, H + (size_t)row2 * DM, F.lane);
            }
        }
    }
    SEAM(PH_COMB_L0);
    if (IN(PH_QKV)) REPS(PH_QKV) {
        pg8::Gemm g{DM, DM, DM}; pg8::DenseOrder S{(const char*)H, (const char*)(ws + WS_WQKV), DM, DM, MT / 256, 24, F.G, bid, 1};
        EpiQKV E{(bf16*)(ws + WS_Q), (size_t)(WS_K - WS_Q) / 2};
        pg8::gemm_phase<EpiQKV, pg8::DenseOrder, true, true, false, true>(ring, g, S, E);
    }
    SEAM(PH_QKV);
#if !(K_NORM_IN_NA && NA_CONV_OVERLAP)
    if (IN(PH_QKNORM)) { qk_norm(args, F);
#if !NA_CONV_OVERLAP
        moe_convert_items(args, F, 1, F.gw, F.NGW);
#endif
    }
    SEAM(PH_QKNORM);
#endif
    if (IN(PH_NA)) REPS(PH_NA) {
#if NA_NAIVE
        na_naive(args, F);
#elif NA_CONV_OVERLAP
        {
            unsigned* qcv = (unsigned*)ctl + CW_QCV; const bool xq = (F.G % 8 == 0); const int xcd = xq ? (bid & 7) : 0;
            unsigned* qna = (unsigned*)ctl + CW_QNA + 32 * xcd; const int qb = xq ? xcd * (NB * NAH * 2) : 0, qe = xq ? qb + NB * NAH * 2 : NB * NAH * 16;
            const bool convFirst = ((bid >> 3) & 7) < NA_CONV_FIRST_E;
#pragma nounroll
            for (int pass = 0; pass < 2; ++pass) {
                if ((pass == 0) == convFirst) moe_convert_dyn(args, F, 1, qcv);
                else na_fast<true>(args, F, qna, qb, qe);
            }
        }
#else
        na_fast<false>(args, F, nullptr, 0, 0);
#endif
    }
    SEAM(PH_NA);
    if (IN(PH_NAO)) {
        pg8::Gemm g{DM, DM, DM}; pg8::DenseOrder S{(const char*)(ws + WS_O), (const char*)(ws + WS_WNAO), DM, DM, NX / 256, 8, F.G, bid, 0};
        EpiRes<false> E{nullptr, nullptr, XA, MOD + (size_t)5 * MODW + 2 * DM};
        pg8::gemm_phase<EpiRes<false>, pg8::DenseOrder, true, true>(ring, g, S, E);
    }
    SEAM(PH_NAO);
    if (IN(PH_MOD2_L1)) REPS(PH_MOD2_L1) {
        LAS float* mods = (LAS float*)F.lds;
        __syncthreads(); stage_mod_lds(mods, args.in[I_N2G] + DM, MOD + (size_t)5 * MODW, 3 * DM, 4 * DM, F.tid); __syncthreads();
        for (int row = F.gw; row < NX; row += 2 * F.NGW) {
            const int row2 = row + F.NGW; const bool has2 = row2 < NX; const int rr2 = has2 ? row2 : row;
            const float* mr = MOD + (size_t)(5 + (row >> 12)) * MODW; const float* mr2 = MOD + (size_t)(5 + (rr2 >> 12)) * MODW;
            f32x4 v[8], v2[8]; load_row_bf16(XA + (size_t)row * DM, v, F.lane); load_row_bf16(XA + (size_t)rr2 * DM, v2, F.lane);
            const int mi = row >> 12, mi2 = rr2 >> 12;
            modulate_store_lds(v, mods, mods + DM + 2 * mi * DM, mods + DM + (2 * mi + 1) * DM, H + (size_t)row * DM, F.lane);
            if (has2) modulate_store_lds(v2, mods, mods + DM + 2 * mi2 * DM, mods + DM + (2 * mi2 + 1) * DM, H + (size_t)row2 * DM, F.lane);
        }
    }
    SEAM(PH_MOD2_L1);
    MOE_PHASES(1, NX, CW_CNT1, PH_ROUTER_L1, PH_ROUTE_L1, PH_GU_L1, PH_DOWN_L1)
    if (IN(PH_COMB_L1)) REPS(PH_COMB_L1) {
        (void)moe_tables(F, (const unsigned*)ctl + CW_CNT1);
        LAS float* g2s = (LAS float*)F.lds;
        for (int i = F.tid; i < 5 * DM / 4; i += 512) { const int r = i / (DM / 4), c = (i % (DM / 4)) * 4; *(LAS f32x4*)(g2s + r * DM + c) = *(const f32x4*)(MOD + (size_t)(5 + r) * MODW + 5 * DM + c); }
        __syncthreads();
        for (int row = F.gw; row < NX; row += 2 * F.NGW) {
            const int row2 = row + F.NGW; const bool has2 = row2 < NX; const int rr2 = has2 ? row2 : row;
            f32x4 v[8], v2[8]; moe_combine_row(args, (const LAS int*)(F.lds + LDS_TAB) + 384, g2s, row, 1, v, F.lane); moe_combine_row(args, (const LAS int*)(F.lds + LDS_TAB) + 384, g2s, rr2, 1, v2, F.lane);
#pragma unroll
            for (int j = 0; j < 8; ++j) *(f32x4*)(args.out + (size_t)row * DM + 4 * F.lane + 256 * j) = v[j];
            if (has2) {
#pragma unroll
                for (int j = 0; j < 8; ++j) *(f32x4*)(args.out + (size_t)row2 * DM + 4 * F.lane + 256 * j) = v2[j];
            }
        }
    }
#undef IN
#undef SEAM
}

extern "C" void kernel_launch(void* const* d_in, const int* in_sizes, int n_in, void* d_out, int out_size, void* d_ws, size_t ws_size, hipStream_t stream) {
    static int grid = 0;
    if (grid == 0) {
        if (n_in != 32 || out_size != NX * DM || ws_size < WS_YD  ) { fprintf(stderr, "kernel_launch: unexpected shapes (n_in %d, out %d, ws %zu)\n", n_in, out_size, ws_size); grid = -1; return; }
        int dev = 0, cus = 0, per_cu = 0;
        if (hipGetDevice(&dev) != hipSuccess || hipDeviceGetAttribute(&cus, hipDeviceAttributeMultiprocessorCount, dev) != hipSuccess) { grid = -1; return; }
        if (hipFuncSetAttribute((const void*)fwd_kernel, hipFuncAttributeMaxDynamicSharedMemorySize, LDS_BYTES) != hipSuccess) { fprintf(stderr, "kernel_launch: hipFuncSetAttribute failed\n"); grid = -1; return; }
        if (hipOccupancyMaxActiveBlocksPerMultiprocessor(&per_cu, (const void*)fwd_kernel, 512, LDS_BYTES) != hipSuccess || per_cu < 1) fprintf(stderr, "kernel_launch: occupancy query says %d\n", per_cu);
        (void)hipGetLastError();
        grid = cus;
    }
    if (grid < 0) return;
    (void)hipMemsetAsync((char*)d_ws + WS_CTL, 0, CTL_ZERO_BYTES, stream);
    Args a{};
    for (int i = 0; i < 32; ++i) a.in[i] = (const float*)d_in[i];
    a.out = (float*)d_out; a.ws = (unsigned char*)d_ws; a.pad = 0;
#if MK_PER_PHASE
    for (int p = 0; p < NPH; ++p) { a.ph_lo = p; a.ph_hi = p + 1; a.use_bar = 0; hipLaunchKernelGGL(fwd_kernel, dim3(grid), dim3(512), LDS_BYTES, stream, a); }
#else
    a.ph_lo = 0; a.ph_hi = NPH; a.use_bar = 1;
    hipLaunchKernelGGL(fwd_kernel, dim3(grid), dim3(512), LDS_BYTES, stream, a);
#endif
}
```
